# Optimizing an MI355X kernel written in HIP

```python
import math
import jax
import jax.numpy as jnp
from jax import lax
import numpy as np

D_MODEL = 1024
BATCH = 16
SEQ = 2048
DEPTH = 2

CTX_LEN = 256
GRID_W = 64
MIX_WIDTH = D_MODEL
GROUP_W = MIX_WIDTH // 4
HEAD = 64
N_RWKV_HEADS = GROUP_W // HEAD
DECAY_LORA = 64
AAA_LORA = 64
GATE_LORA = 128
LORA_COLS = 2 * DECAY_LORA + 2 * AAA_LORA + GATE_LORA
LORA_SPLITS = (DECAY_LORA, 2 * DECAY_LORA, 2 * DECAY_LORA + AAA_LORA, 2 * DECAY_LORA + 2 * AAA_LORA)
POOL_WINDOWS = (2, 4, 8, 16)
POOL_GROUPS = 4
POOL_CH = GROUP_W // POOL_GROUPS
CHUNK = 128
GMLP_GROUPS = 4
GMLP_CH = GROUP_W // GMLP_GROUPS
FNET_GROUPS = 4
FNET_CH = GROUP_W // FNET_GROUPS
RWKV_COLS = 3 * GROUP_W + LORA_COLS
IN_COLS = RWKV_COLS + GROUP_W + 2 * GROUP_W + GROUP_W
IN_SPLITS = (3 * GROUP_W, RWKV_COLS, RWKV_COLS + GROUP_W, RWKV_COLS + 3 * GROUP_W)
D_FF = -(-8 * D_MODEL // (3 * 256)) * 256
ALPHA = (2 * DEPTH) ** 0.25
BETA = (8 * DEPTH) ** -0.25
LN_EPS = 1e-5
GN_EPS = 64e-5

kernel_name = 'hybrid_rwkv_pool_gmlp_fnet_dit'


def layer_norm(x, g, b, eps=LN_EPS):
    xf = x.astype(jnp.float32)
    mu = jnp.mean(xf, -1, keepdims=True)
    var = jnp.mean(jnp.square(xf - mu), -1, keepdims=True)
    return ((xf - mu) * lax.rsqrt(var + eps) * g.astype(jnp.float32) + b.astype(jnp.float32)).astype(x.dtype)


def pos_embed_2d(n_tok, dim, dtype):
    rows = n_tok // GRID_W
    row, col = jnp.meshgrid(jnp.arange(rows, dtype=jnp.float32), jnp.arange(GRID_W, dtype=jnp.float32), indexing='ij')
    quarter = dim // 4
    freqs = jnp.exp(-math.log(10000.0) * jnp.arange(quarter, dtype=jnp.float32) / quarter)
    def enc(p):
        ang = p.reshape(-1, 1) * freqs[None, :]
        return jnp.concatenate([jnp.sin(ang), jnp.cos(ang)], -1)
    return jnp.concatenate([enc(row), enc(col)], -1).astype(dtype)


def modulation(cond, w, b):
    m = (jax.nn.silu(cond) @ w + b)[..., None, :]
    return jnp.split(m, 6, axis=-1)


def short_conv(z, w):
    zp = jnp.pad(z, ((0, 0), (1, 1), (0, 0)))
    return zp[:, :-2] * w[0] + zp[:, 1:-1] * w[1] + zp[:, 2:] * w[2]


def rwkv_prep(z_rkv, z_lora, conv, w0, w2, a0, a2, k_k, k_a):
    B, L, _ = z_rkv.shape
    def heads(t):
        return t.reshape(B, L, N_RWKV_HEADS, HEAD).astype(jnp.float32)
    r, k, v = jnp.split(short_conv(z_rkv, conv), 3, axis=-1)
    dw_f, dw_b, da_f, da_b, dg = jnp.split(z_lora, LORA_SPLITS, axis=-1)
    kk = heads(k * k_k)
    kk = kk / jnp.maximum(jnp.sqrt(jnp.sum(kk * kk, -1, keepdims=True)), 1e-12)
    kf = k.astype(jnp.float32)
    dirs = []
    for d, (dw, da) in enumerate(((dw_f, da_f), (dw_b, da_b))):
        logw = -jax.nn.softplus(-(w0[d] + jnp.tanh(dw) @ w2[d]).astype(jnp.float32)) - 0.5
        decay = jnp.exp(-jnp.exp(logw))
        a = jax.nn.sigmoid((a0[d] + da @ a2[d]).astype(jnp.float32))
        k_d = kf * (1.0 + (a - 1.0) * k_a.astype(jnp.float32))
        dirs.append((heads(k_d), heads(decay), heads(a)))
    return heads(r), heads(v), kk, dg, dirs


def rwkv_scan(prep, direction, s0):
    r, v, kk, _, dirs = prep
    k, decay, a = dirs[direction]
    def step(S, inp):
        r_t, k_t, v_t, w_t, kk_t, a_t = inp
        s_kk = jnp.einsum('bhvk,bhk->bhv', S, -kk_t)
        S = (S * w_t[:, :, None, :]
             + s_kk[..., None] * (kk_t * a_t)[:, :, None, :]
             + v_t[..., None] * k_t[:, :, None, :])
        return S, jnp.einsum('bhvk,bhk->bhv', S, r_t)
    xs = tuple(jnp.moveaxis(t, 1, 0) for t in (r, k, v, decay, kk, a))
    s_final, ys = lax.scan(step, s0, xs, reverse=(direction == 1))
    return jnp.moveaxis(ys, 0, 1), s_final


def rwkv_readout(prep, y_f, y_b, r_k, gn_g, gn_b, gate_g2):
    r, v, kk, dg, dirs = prep
    B, L, H, N = r.shape
    y = y_f + y_b
    mu = jnp.mean(y, -1, keepdims=True)
    var = jnp.mean(jnp.square(y - mu), -1, keepdims=True)
    y = (y - mu) * lax.rsqrt(var + GN_EPS)
    bonus = jnp.sum(r * (dirs[0][0] + dirs[1][0]) * r_k.astype(jnp.float32), -1, keepdims=True) * v
    y = y.reshape(B, L, H * N) * gn_g.astype(jnp.float32) + gn_b.astype(jnp.float32) + bonus.reshape(B, L, H * N)
    gate = jax.nn.sigmoid(dg) @ gate_g2
    return (y * gate.astype(jnp.float32)).astype(dg.dtype)


def pool_mixer(z, pool_w, pool_scale):
    B, L, _ = z.shape
    zg = z.reshape(B, L, POOL_GROUPS, POOL_CH).astype(jnp.float32)
    cs = jnp.pad(jnp.cumsum(zg, axis=1), ((0, 0), (1, 0), (0, 0), (0, 0)))
    pos = jnp.arange(L)
    pooled = []
    for gi, w in enumerate(POOL_WINDOWS):
        lo = jnp.clip(pos - w // 2, 0, L)
        hi = jnp.clip(pos + w - w // 2, 0, L)
        cnt = (hi - lo).astype(jnp.float32)[None, :, None]
        pooled.append((cs[:, hi, gi] - cs[:, lo, gi]) / cnt)
    d = (jnp.stack(pooled, axis=2) - zg).astype(z.dtype)
    y = jnp.einsum('blgc,gcd->blgd', d, pool_w)
    return y.reshape(B, L, GROUP_W) * pool_scale


def gmlp_mixer(z, ln_g, ln_b, ws, bs):
    B, L, _ = z.shape
    u, v = jnp.split(jax.nn.gelu(z), 2, axis=-1)
    v = v.reshape(B, L // CHUNK, CHUNK, GMLP_GROUPS, GMLP_CH)
    v = layer_norm(v, ln_g.reshape(GMLP_GROUPS, GMLP_CH), ln_b.reshape(GMLP_GROUPS, GMLP_CH))
    sv = jnp.einsum('gpq,bnqgc->bnpgc', ws, v) + bs.T[None, None, :, :, None]
    return u * sv.reshape(B, L, GROUP_W)


def fourier_mixer(z, fnet_w, fnet_b):
    B, L, _ = z.shape
    zg = jnp.transpose(z.reshape(B, L, FNET_GROUPS, FNET_CH).astype(jnp.float32), (0, 2, 1, 3))
    f = jnp.transpose(jnp.fft.fft2(zg, norm='ortho').real, (0, 2, 1, 3)).astype(z.dtype)
    return jnp.einsum('blgc,gcd->blgd', f, fnet_w).reshape(B, L, GROUP_W) + fnet_b


def mix_out(parts, prep, y_f, y_b, r_k, gn_g, gn_b, gate_g2, pool_w, pool_scale,
            gmlp_ln_g, gmlp_ln_b, gmlp_ws, gmlp_bs, fnet_w, fnet_b, w_out):
    a = rwkv_readout(prep, y_f, y_b, r_k, gn_g, gn_b, gate_g2)
    b = pool_mixer(parts[2], pool_w, pool_scale)
    g = gmlp_mixer(parts[3], gmlp_ln_g, gmlp_ln_b, gmlp_ws, gmlp_bs)
    f = fourier_mixer(parts[4], fnet_w, fnet_b)
    return jnp.concatenate([a, b, g, f], axis=-1) @ w_out


def swiglu(h, w1, w2):
    gate, up = jnp.split(h @ w1, 2, axis=-1)
    return (jax.nn.silu(gate) * up) @ w2


def setup_inputs(seed: int = 0) -> dict:
    key = jax.random.key(seed)
    ks = iter(jax.random.split(key, 40))
    def nrm(shape, s):
        return s * jax.random.normal(next(ks), shape, jnp.float32)
    D = D_MODEL
    centre = jnp.asarray([0.0, 1.0, 0.0], jnp.float32)[None, :, None]
    return {
        'x': nrm((BATCH, SEQ, D), 1.0),
        'c': nrm((BATCH, D), 1.0),
        'ctx': nrm((BATCH, CTX_LEN, D), 1.0),
        'c_ctx': nrm((D,), 1.0),
        'w_mod': nrm((DEPTH, D, 6 * D), 0.5 * D ** -0.5),
        'b_mod': nrm((DEPTH, 6 * D), 0.01),
        'w_in': nrm((DEPTH, D, IN_COLS), D ** -0.5),
        'rkv_conv': centre + nrm((DEPTH, 3, 3 * GROUP_W), 0.3),
        'decay_w0': nrm((DEPTH, 2, GROUP_W), 1.0),
        'decay_w2': nrm((DEPTH, 2, DECAY_LORA, GROUP_W), 0.5 * DECAY_LORA ** -0.5),
        'iclr_a0': nrm((DEPTH, 2, GROUP_W), 0.5),
        'iclr_a2': nrm((DEPTH, 2, AAA_LORA, GROUP_W), 0.5 * AAA_LORA ** -0.5),
        'gate_g2': nrm((DEPTH, GATE_LORA, GROUP_W), GATE_LORA ** -0.5),
        'k_k': 0.85 + nrm((DEPTH, GROUP_W), 0.05),
        'k_a': 1.0 + nrm((DEPTH, GROUP_W), 0.05),
        'r_k': nrm((DEPTH, N_RWKV_HEADS, HEAD), 0.1),
        'gn_g': 1.0 + nrm((DEPTH, GROUP_W), 0.05),
        'gn_b': nrm((DEPTH, GROUP_W), 0.01),
        'pool_w': nrm((DEPTH, POOL_GROUPS, POOL_CH, POOL_CH), POOL_CH ** -0.5),
        'pool_scale': 1.0 + nrm((DEPTH, GROUP_W), 0.1),
        'gmlp_ln_g': 1.0 + nrm((DEPTH, GROUP_W), 0.05),
        'gmlp_ln_b': nrm((DEPTH, GROUP_W), 0.01),
        'gmlp_ws': nrm((DEPTH, GMLP_GROUPS, CHUNK, CHUNK), CHUNK ** -0.5),
        'gmlp_bs': 1.0 + nrm((DEPTH, GMLP_GROUPS, CHUNK), 0.1),
        'fnet_w': nrm((DEPTH, FNET_GROUPS, FNET_CH, FNET_CH), FNET_CH ** -0.5),
        'fnet_b': nrm((DEPTH, GROUP_W), 0.01),
        'w_out': nrm((DEPTH, MIX_WIDTH, D), BETA * MIX_WIDTH ** -0.5),
        'ln1_g': 1.0 + nrm((DEPTH, D), 0.1),
        'ln1_b': nrm((DEPTH, D), 0.01),
        'ln2_g': 1.0 + nrm((DEPTH, D), 0.1),
        'ln2_b': nrm((DEPTH, D), 0.01),
        'ffn_w1': nrm((DEPTH, D, 2 * D_FF), D ** -0.5),
        'ffn_w2': nrm((DEPTH, D_FF, D), BETA * D_FF ** -0.5),
    }


def reference(x, c, ctx, c_ctx, w_mod, b_mod, w_in, rkv_conv, decay_w0, decay_w2, iclr_a0, iclr_a2,
              gate_g2, k_k, k_a, r_k, gn_g, gn_b, pool_w, pool_scale, gmlp_ln_g, gmlp_ln_b, gmlp_ws,
              gmlp_bs, fnet_w, fnet_b, w_out, ln1_g, ln1_b, ln2_g, ln2_b, ffn_w1, ffn_w2):
    B, L, D = x.shape
    xs = x + pos_embed_2d(L, D, x.dtype)[None]
    cs = ctx
    s0 = jnp.zeros((B, N_RWKV_HEADS, HEAD, HEAD), jnp.float32)
    for l in range(DEPTH):
        last = l == DEPTH - 1
        sh1, sc1, g1, sh2, sc2, g2 = modulation(c, w_mod[l], b_mod[l])
        csh1, csc1, cg1, csh2, csc2, cg2 = modulation(c_ctx[None], w_mod[l], b_mod[l])
        hx = xs * (1.0 + sc1) + sh1
        hc = cs * (1.0 + csc1) + csh1
        px = jnp.split(hx @ w_in[l], IN_SPLITS, axis=-1)
        if last:
            pc = jnp.split(hc @ w_in[l][:, :RWKV_COLS], (3 * GROUP_W,), axis=-1)
        else:
            pc = jnp.split(hc @ w_in[l], IN_SPLITS, axis=-1)
        rw = (rkv_conv[l], decay_w0[l], decay_w2[l], iclr_a0[l], iclr_a2[l], k_k[l], k_a[l])
        prep_c = rwkv_prep(pc[0], pc[1], *rw)
        prep_x = rwkv_prep(px[0], px[1], *rw)
        yc_f, sc_f = rwkv_scan(prep_c, 0, s0)
        yc_b, sc_b = rwkv_scan(prep_c, 1, s0)
        yx_f, _ = rwkv_scan(prep_x, 0, sc_f)
        yx_b, _ = rwkv_scan(prep_x, 1, sc_b)
        op = (r_k[l], gn_g[l], gn_b[l], gate_g2[l], pool_w[l], pool_scale[l], gmlp_ln_g[l], gmlp_ln_b[l],
              gmlp_ws[l], gmlp_bs[l], fnet_w[l], fnet_b[l], w_out[l])
        mix_x = mix_out(px, prep_x, yx_f, yx_b, *op)
        xs = layer_norm(ALPHA * xs + g1 * mix_x, ln1_g[l], ln1_b[l])
        xs = layer_norm(ALPHA * xs + g2 * swiglu(xs * (1.0 + sc2) + sh2, ffn_w1[l], ffn_w2[l]), ln2_g[l], ln2_b[l])
        if not last:
            mix_c = mix_out(pc, prep_c, yc_f, yc_b, *op)
            cs = layer_norm(ALPHA * cs + cg1 * mix_c, ln1_g[l], ln1_b[l])
            cs = layer_norm(ALPHA * cs + cg2 * swiglu(cs * (1.0 + csc2) + csh2, ffn_w1[l], ffn_w2[l]), ln2_g[l], ln2_b[l])
    return xs
```

```cpp
#include <hip/hip_runtime.h>
#include <cstdint>
#include <cstdio>

typedef unsigned short bf16_t;
typedef short bf16x8 __attribute__((ext_vector_type(8)));
typedef float f32x4 __attribute__((ext_vector_type(4)));
typedef unsigned u32x2 __attribute__((ext_vector_type(2)));
typedef unsigned u32x4 __attribute__((ext_vector_type(4)));

constexpr int D = 1024, NB = 16, SEQ = 2048, CTXL = 256, DEPTH = 2;
constexpr int MX = NB * SEQ;
constexpr int MC = NB * CTXL;
constexpr int MT = MX + MC;
constexpr int GW = 256;
constexpr int INC = 2176;
constexpr int ZW = 2048;
constexpr int DFF = 2816;
constexpr float ALPHA = 1.4142135623730951f;
constexpr float LN_EPS = 1e-5f, GN_EPS = 64e-5f;
constexpr int ZC_R = 0, ZC_K = 256, ZC_V = 512, ZC_DW = 768, ZC_DA = 896, ZC_DG = 1024, ZC_POOL = 1280, ZC_GU = 1536, ZC_GV = 1792;

constexpr size_t MiB = 1u << 20;
constexpr size_t WS_CTL = 0;
constexpr size_t WS_MOD = 1 * MiB;
constexpr size_t WS_WCS = 2 * MiB;
constexpr size_t WS_POS = 10 * MiB;
constexpr size_t WS_WIN = 18 * MiB;
constexpr size_t WS_WF = 26 * MiB;
constexpr size_t WS_WOUT = 28 * MiB;
constexpr size_t WS_W1 = 32 * MiB;
constexpr size_t WS_W2 = 54 * MiB;
constexpr size_t WS_DFTX = 65 * MiB;
constexpr size_t WS_DFTC = 81 * MiB;
constexpr size_t WS_XSC = 82 * MiB;
constexpr size_t WS_A = 98 * MiB;
constexpr size_t WS_Z = 170 * MiB;
constexpr size_t WS_CAT = 314 * MiB;
constexpr size_t WS_H = 170 * MiB;
constexpr size_t WS_ZTX = 386 * MiB;
constexpr size_t WS_ZTC = 418 * MiB;
constexpr size_t WS_Y = 422 * MiB;
constexpr size_t WS_BS = 458 * MiB;
constexpr size_t WS_END = 460 * MiB;

__device__ __forceinline__ unsigned f2bf(float f) { unsigned u = __float_as_uint(f); return (u + 0x7fffu + ((u >> 16) & 1u)) >> 16; }
__device__ __forceinline__ float bf2f(bf16_t h) { return __uint_as_float(((unsigned)h) << 16); }
__device__ __forceinline__ unsigned pk2(float lo, float hi) { return f2bf(lo) | (f2bf(hi) << 16); }
__device__ __forceinline__ float sigmoidf_(float x) { return 1.f / (1.f + __expf(-x)); }
__device__ __forceinline__ float siluf_(float x) { return x / (1.f + __expf(-x)); }
__device__ __forceinline__ float gelu_tanh(float x) { const float u = 0.7978845608028654f * (x + 0.044715f * x * x * x); return 0.5f * x * (1.f + tanhf(u)); }
__device__ __forceinline__ float wave_sum(float v) {
#pragma unroll
    for (int o = 1; o < 64; o <<= 1) v += __shfl_xor(v, o);
    return v;
}
__device__ __forceinline__ int row_cond(int r) { return r < MX ? (r >> 11) : 16; }
__device__ __forceinline__ const float* modp(const float* MOD, int l, int cond, int which) { return MOD + ((size_t)(l * 17 + cond) * 6 + which) * 1024; }

struct Ptrs {
    const float* in[33];
    float* out;
    unsigned char* ws;
};

__global__ void __launch_bounds__(256) k_mod(Ptrs P) {
    const int j = blockIdx.x * 256 + threadIdx.x, r = blockIdx.y, l = blockIdx.z;
    const float* cond = (r < 16) ? P.in[1] + (size_t)r * D : P.in[3];
    const float* w = P.in[4] + (size_t)l * D * 6144;
    float acc = P.in[5][l * 6144 + j];
    for (int k = 0; k < D; ++k) acc += siluf_(cond[k]) * w[(size_t)k * 6144 + j];
    ((float*)(P.ws + WS_MOD))[(size_t)(l * 17 + r) * 6144 + j] = acc;
}
__global__ void __launch_bounds__(256) k_pos(Ptrs P) {
    const int idx = blockIdx.x * 256 + threadIdx.x;
    const int t = idx >> 10, ch = idx & 1023;
    const int q = ch >> 8, i = ch & 255;
    const float f = expf(-9.210340371976184f * (float)i / 256.0f);
    const float p = (q < 2) ? (float)(t >> 6) : (float)(t & 63);
    const float ang = p * f;
    ((float*)(P.ws + WS_POS))[idx] = (q & 1) ? cosf(ang) : sinf(ang);
}
__device__ __forceinline__ int colmap(int n, int mode) {
    if (mode == 0) return n;
    if (mode == 1) { if (n < 1152) return n; if (n < 1280) return -1; return n - 128; }
    const int tile = n >> 8, half = (n >> 7) & 1, j = n & 127; return half * DFF + tile * 128 + j;
}
__global__ void __launch_bounds__(256) k_wtrans(const float* W, int Nsrc, bf16_t* WT, int K, int mode) {
    __shared__ float tile[32][33];
    const int n0 = blockIdx.x * 32, k0 = blockIdx.y * 32, tx = threadIdx.x & 31, ty = threadIdx.x >> 5;
#pragma unroll
    for (int i = 0; i < 4; ++i) { const int kk = ty + 8 * i; const int sc = colmap(n0 + tx, mode); tile[kk][tx] = (sc >= 0) ? W[(size_t)(k0 + kk) * Nsrc + sc] : 0.f; }
    __syncthreads();
#pragma unroll
    for (int i = 0; i < 4; ++i) { const int nn = ty + 8 * i; WT[(size_t)(n0 + nn) * K + k0 + tx] = (bf16_t)f2bf(tile[tx][nn]); }
}
__global__ void __launch_bounds__(256) k_wcs(Ptrs P) {
    const int idx = blockIdx.x * 256 + threadIdx.x;
    const int d = idx & 63, c = (idx >> 6) & 63, s = (idx >> 12) & 1, g = (idx >> 13) & 3, l = idx >> 15;
    const float* fw = P.in[24] + (size_t)(l * 4 + g) * 4096;
    float acc = 0.f;
    for (int m = 0; m < 64; ++m) { const int ii = (m * c) & 63; const float tr = s ? sinpif((float)ii / 32.f) : cospif((float)ii / 32.f); acc += tr * fw[m * 64 + d]; }
    ((float*)(P.ws + WS_WCS))[idx] = acc * 0.125f;
}
__global__ void __launch_bounds__(256) k_wf(Ptrs P) {
    const int idx = blockIdx.x * 256 + threadIdx.x;
    const int d = idx & 63, dm = (idx >> 6) & 1023, g = (idx >> 16) & 3, s = (idx >> 18) & 1, l = idx >> 19;
    const float* wi = P.in[6] + ((size_t)l * D + dm) * INC + 1920 + g * 64;
    const float* wc = (const float*)(P.ws + WS_WCS) + (size_t)(((l * 4 + g) * 2 + s) * 64) * 64 + d;
    float acc = 0.f;
    for (int c = 0; c < 64; ++c) acc += wi[c] * wc[c * 64];
    ((bf16_t*)(P.ws + WS_WF))[((size_t)l * 512 + s * 256 + g * 64 + d) * 1024 + dm] = (bf16_t)f2bf(acc);
}
__global__ void __launch_bounds__(256) k_dft(Ptrs P) {
    const int idx = blockIdx.x * 256 + threadIdx.x;
    if (idx < 2048 * 4096) {
        const int k = idx >> 12, kk = idx & 4095, t = kk & 2047, ii = (k * t) & 2047;
        const float v = (kk < 2048) ? cospif((float)ii / 1024.f) : -sinpif((float)ii / 1024.f);
        ((bf16_t*)(P.ws + WS_DFTX))[idx] = (bf16_t)f2bf(v * 0.022097086912079608f);
    } else {
        const int j = idx - 2048 * 4096; if (j >= 256 * 512) return;
        const int k = j >> 9, kk = j & 511, t = kk & 255, ii = (k * t) & 255;
        const float v = (kk < 256) ? cospif((float)ii / 128.f) : -sinpif((float)ii / 128.f);
        ((bf16_t*)(P.ws + WS_DFTC))[j] = (bf16_t)f2bf(v * 0.0625f);
    }
}
__global__ void __launch_bounds__(256) k_init(Ptrs P) {
    const size_t idx4 = (size_t)blockIdx.x * 256 + threadIdx.x;
    const int r = (int)(idx4 >> 8), c = (int)(idx4 & 255) * 4;
    const float* MOD = (const float*)(P.ws + WS_MOD);
    const int cond = row_cond(r);
    f32x4 v;
    if (r < MX) { v = *(const f32x4*)(P.in[0] + (size_t)r * D + c) + *(const f32x4*)((const float*)(P.ws + WS_POS) + (size_t)(r & 2047) * D + c); *(f32x4*)(P.out + (size_t)r * D + c) = v; }
    else { v = *(const f32x4*)(P.in[2] + (size_t)(r - MX) * D + c); *(f32x4*)((float*)(P.ws + WS_XSC) + (size_t)(r - MX) * D + c) = v; }
    const f32x4 sh = *(const f32x4*)(modp(MOD, 0, cond, 0) + c), sc = *(const f32x4*)(modp(MOD, 0, cond, 1) + c);
    const f32x4 h = v * (sc + 1.0f) + sh;
    u32x2 w; w.x = pk2(h[0], h[1]); w.y = pk2(h[2], h[3]);
    *(u32x2*)((bf16_t*)(P.ws + WS_A) + (size_t)r * D + c) = w;
}

template <class Epi>
__global__ void __launch_bounds__(256) k_gemm(const bf16_t* A, int lda, size_t strideA, const bf16_t* Bt, int ldb, size_t strideB, int K, Epi epi) {
    __shared__ __attribute__((aligned(16))) bf16_t As[128][40];
    __shared__ __attribute__((aligned(16))) bf16_t Bs[256][40];
    const int tid = threadIdx.x, lane = tid & 63, wid = tid >> 6, fr = lane & 15, fq = lane >> 4;
    const int m0 = blockIdx.y * 128, n0 = blockIdx.x * 256, bz = blockIdx.z;
    A += (size_t)bz * strideA; Bt += (size_t)bz * strideB;
    f32x4 acc[2][16];
#pragma unroll
    for (int i = 0; i < 2; ++i)
#pragma unroll
        for (int j = 0; j < 16; ++j) acc[i][j] = (f32x4){0.f, 0.f, 0.f, 0.f};
    for (int k0 = 0; k0 < K; k0 += 32) {
#pragma unroll
        for (int i = 0; i < 2; ++i) { const int c = tid + i * 256, r = c >> 2, cc = (c & 3) * 8; *(u32x4*)&As[r][cc] = *(const u32x4*)(A + (size_t)(m0 + r) * lda + k0 + cc); }
#pragma unroll
        for (int i = 0; i < 4; ++i) { const int c = tid + i * 256, r = c >> 2, cc = (c & 3) * 8; *(u32x4*)&Bs[r][cc] = *(const u32x4*)(Bt + (size_t)(n0 + r) * ldb + k0 + cc); }
        __syncthreads();
        bf16x8 a[2];
#pragma unroll
        for (int mt = 0; mt < 2; ++mt) a[mt] = *(const bf16x8*)&As[wid * 32 + mt * 16 + fr][fq * 8];
#pragma unroll
        for (int nt = 0; nt < 16; ++nt) {
            const bf16x8 b = *(const bf16x8*)&Bs[nt * 16 + fr][fq * 8];
#pragma unroll
            for (int mt = 0; mt < 2; ++mt) acc[mt][nt] = __builtin_amdgcn_mfma_f32_16x16x32_bf16(b, a[mt], acc[mt][nt], 0, 0, 0);
        }
        __syncthreads();
    }
#pragma unroll
    for (int mt = 0; mt < 2; ++mt) {
        const int row = m0 + wid * 32 + mt * 16 + fr;
        if constexpr (Epi::PAIR) {
#pragma unroll
            for (int nt = 0; nt < 8; ++nt) epi.pair(bz, row, blockIdx.x, nt * 16 + 4 * fq, acc[mt][nt], acc[mt][nt + 8]);
        } else {
#pragma unroll
            for (int nt = 0; nt < 16; ++nt) epi(bz, row, n0 + nt * 16 + 4 * fq, acc[mt][nt]);
        }
    }
}

struct EpiInproj {
    static constexpr bool PAIR = false;
    bf16_t* Z; int row0; int pad;
    __device__ __forceinline__ void operator()(int, int row, int col, f32x4 v) const {
        if (col >= ZC_GU) { v[0] = gelu_tanh(v[0]); v[1] = gelu_tanh(v[1]); v[2] = gelu_tanh(v[2]); v[3] = gelu_tanh(v[3]); }
        else if (col >= ZC_DW && col < ZC_DA) { v[0] = tanhf(v[0]); v[1] = tanhf(v[1]); v[2] = tanhf(v[2]); v[3] = tanhf(v[3]); }
        else if (col >= ZC_DG && col < ZC_DG + 128) { v[0] = sigmoidf_(v[0]); v[1] = sigmoidf_(v[1]); v[2] = sigmoidf_(v[2]); v[3] = sigmoidf_(v[3]); }
        u32x2 w; w.x = pk2(v[0], v[1]); w.y = pk2(v[2], v[3]);
        *(u32x2*)(Z + (size_t)(row0 + row) * ZW + col) = w;
    }
};
struct EpiFnetT {
    static constexpr bool PAIR = false;
    bf16_t* ZTX; bf16_t* ZTC; int tok0; int pad;
    __device__ __forceinline__ void operator()(int, int row, int col, f32x4 v) const {
        const int s = row >> 8, n = row & 255, tok = tok0 + col;
        u32x2 w; w.x = pk2(v[0], v[1]); w.y = pk2(v[2], v[3]);
        if (tok < MX) { const int b = tok >> 11, t = tok & 2047; *(u32x2*)(ZTX + ((size_t)(b * 256 + n) * 4096 + s * 2048 + t)) = w; }
        else { const int tc = tok - MX, b = tc >> 8, t = tc & 255; *(u32x2*)(ZTC + ((size_t)(b * 256 + n) * 512 + s * 256 + t)) = w; }
    }
};
struct EpiFourier {
    static constexpr bool PAIR = false;
    bf16_t* Cat; const float* fb; int rowbase, Ls;
    __device__ __forceinline__ void operator()(int bz, int row, int col, f32x4 v) const {
        const f32x4 b = *(const f32x4*)(fb + col); v = v + b;
        u32x2 w; w.x = pk2(v[0], v[1]); w.y = pk2(v[2], v[3]);
        *(u32x2*)(Cat + (size_t)(rowbase + bz * Ls + row) * D + 768 + col) = w;
    }
};
struct EpiRes {
    static constexpr bool PAIR = false;
    float* out; float* xsc; const float* MOD; int l, which;
    __device__ __forceinline__ void operator()(int, int row, int col, f32x4 v) const {
        float* p = (row < MX) ? out + (size_t)row * D + col : xsc + (size_t)(row - MX) * D + col;
        const f32x4 g = *(const f32x4*)(modp(MOD, l, row_cond(row), which) + col);
        const f32x4 x = *(const f32x4*)p;
        *(f32x4*)p = x * ALPHA + g * v;
    }
};
struct EpiSwiglu {
    static constexpr bool PAIR = true;
    bf16_t* H;
    __device__ __forceinline__ void pair(int, int row, int tile, int j, f32x4 g, f32x4 u) const {
        f32x4 h; h[0] = siluf_(g[0]) * u[0]; h[1] = siluf_(g[1]) * u[1]; h[2] = siluf_(g[2]) * u[2]; h[3] = siluf_(g[3]) * u[3];
        u32x2 w; w.x = pk2(h[0], h[1]); w.y = pk2(h[2], h[3]);
        *(u32x2*)(H + (size_t)row * DFF + tile * 128 + j) = w;
    }
};

__global__ void __launch_bounds__(64) k_scan_naive(Ptrs P, int l) {
    __shared__ float sv[5][64];
    const int lane = threadIdx.x, bid = blockIdx.x, d = bid & 1, h = (bid >> 1) & 3, b = bid >> 3;
    const int ch = h * 64 + lane;
    const bf16_t* Z = (const bf16_t*)(P.ws + WS_Z);
    bf16_t* Y = (bf16_t*)(P.ws + WS_Y) + (size_t)d * MT * GW;
    float* BS = (float*)(P.ws + WS_BS);
    const float* conv = P.in[7] + (size_t)l * 3 * 768;
    const float cw[3][3] = {{conv[ch], conv[768 + ch], conv[1536 + ch]}, {conv[256 + ch], conv[768 + 256 + ch], conv[1536 + 256 + ch]}, {conv[512 + ch], conv[768 + 512 + ch], conv[1536 + 512 + ch]}};
    const float w0 = P.in[8][(l * 2 + d) * GW + ch], a0 = P.in[10][(l * 2 + d) * GW + ch];
    const float* w2 = P.in[9] + (size_t)(l * 2 + d) * 64 * GW + ch;
    const float* a2 = P.in[11] + (size_t)(l * 2 + d) * 64 * GW + ch;
    const float kkw = P.in[13][l * GW + ch], kaw = P.in[14][l * GW + ch], rkw = P.in[15][l * GW + ch];
    float S[64];
#pragma unroll
    for (int k = 0; k < 64; ++k) S[k] = 0.f;
    for (int seg = 0; seg < 2; ++seg) {
        const int Ls = seg == 0 ? CTXL : SEQ;
        const int base = seg == 0 ? MX + b * CTXL : b * SEQ;
        for (int s = 0; s < Ls; ++s) {
            const int t = d ? (Ls - 1 - s) : s;
            const size_t row = (size_t)(base + t);
            const bf16_t* zr = Z + row * ZW;
            float rkv[3];
#pragma unroll
            for (int q = 0; q < 3; ++q) {
                const int col = q * 256 + ch;
                float a = cw[q][1] * bf2f(zr[col]);
                if (t > 0) a += cw[q][0] * bf2f(zr[col - ZW]);
                if (t < Ls - 1) a += cw[q][2] * bf2f(zr[col + ZW]);
                rkv[q] = a;
            }
            const float r = rkv[0], k = rkv[1], v = rkv[2];
            const float kkr = k * kkw;
            const float nrm = sqrtf(wave_sum(kkr * kkr));
            const float kk = kkr / fmaxf(nrm, 1e-12f);
            float lw = w0, av = a0;
            for (int j = 0; j < 64; ++j) { lw += bf2f(zr[ZC_DW + d * 64 + j]) * w2[j * GW]; av += bf2f(zr[ZC_DA + d * 64 + j]) * a2[j * GW]; }
            const float nx = -lw;
            const float sp = fmaxf(nx, 0.f) + log1pf(expf(-fabsf(nx)));
            const float logw = -sp - 0.5f;
            const float w = expf(-expf(logw));
            const float a = 1.f / (1.f + expf(-av));
            const float kd = k * (1.f + (a - 1.f) * kaw);
            const float bsum = wave_sum(r * kd * rkw);
            if (lane == 0) BS[row * 8 + h * 2 + d] = bsum;
            __syncthreads();
            sv[0][lane] = w; sv[1][lane] = kk; sv[2][lane] = kk * a; sv[3][lane] = kd; sv[4][lane] = r;
            __syncthreads();
            float skk = 0.f;
#pragma unroll
            for (int q = 0; q < 64; ++q) skk -= S[q] * sv[1][q];
            float y = 0.f;
#pragma unroll
            for (int q = 0; q < 64; ++q) { S[q] = S[q] * sv[0][q] + skk * sv[2][q] + v * sv[3][q]; y += S[q] * sv[4][q]; }
            Y[row * GW + ch] = (bf16_t)f2bf(y);
        }
    }
}
__global__ void __launch_bounds__(256) k_readout_naive(Ptrs P, int l, int row0) {
    __shared__ float sg[128];
    const int row = row0 + blockIdx.x, ch = threadIdx.x, h = ch >> 6;
    const int t = row < MX ? (row & 2047) : ((row - MX) & 255), Ls = row < MX ? SEQ : CTXL;
    const bf16_t* Z = (const bf16_t*)(P.ws + WS_Z) + (size_t)row * ZW;
    const bf16_t* Yf = (const bf16_t*)(P.ws + WS_Y) + (size_t)row * GW;
    const bf16_t* Yb = Yf + (size_t)MT * GW;
    const float* BS = (const float*)(P.ws + WS_BS) + (size_t)row * 8;
    if (ch < 128) sg[ch] = bf2f(Z[ZC_DG + ch]);
    __syncthreads();
    const float y = bf2f(Yf[ch]) + bf2f(Yb[ch]);
    const float mu = wave_sum(y) * (1.f / 64.f);
    const float dv = y - mu;
    const float var = wave_sum(dv * dv) * (1.f / 64.f);
    const float* conv = P.in[7] + (size_t)l * 3 * 768 + 512 + ch;
    float v = conv[768] * bf2f(Z[ZC_V + ch]);
    if (t > 0) v += conv[0] * bf2f(Z[ZC_V + ch - ZW]);
    if (t < Ls - 1) v += conv[1536] * bf2f(Z[ZC_V + ch + ZW]);
    const float* g2 = P.in[12] + (size_t)l * 128 * GW + ch;
    float gate = 0.f;
    for (int j = 0; j < 128; ++j) gate += sg[j] * g2[j * GW];
    const float o = (dv * rsqrtf(var + GN_EPS) * P.in[16][l * GW + ch] + P.in[17][l * GW + ch] + (BS[h * 2] + BS[h * 2 + 1]) * v) * gate;
    ((bf16_t*)(P.ws + WS_CAT))[(size_t)row * D + ch] = (bf16_t)f2bf(o);
}
__global__ void __launch_bounds__(256) k_pool_naive(Ptrs P, int l, int row0) {
    __shared__ float sd[256];
    const int row = row0 + blockIdx.x, ch = threadIdx.x, g = ch >> 6;
    const int t = row < MX ? (row & 2047) : ((row - MX) & 255), Ls = row < MX ? SEQ : CTXL;
    const bf16_t* Z = (const bf16_t*)(P.ws + WS_Z) + (size_t)row * ZW + ZC_POOL + ch;
    const int w = 2 << g;
    int lo = t - w / 2; if (lo < 0) lo = 0;
    int hi = t + w - w / 2; if (hi > Ls) hi = Ls;
    float s = 0.f;
    for (int i = lo; i < hi; ++i) s += bf2f(Z[(ptrdiff_t)(i - t) * ZW]);
    sd[ch] = s / (float)(hi - lo) - bf2f(Z[0]);
    __syncthreads();
    const float* pw = P.in[18] + (size_t)(l * 4 + g) * 4096 + (ch & 63);
    float acc = 0.f;
    for (int c = 0; c < 64; ++c) acc += sd[g * 64 + c] * pw[c * 64];
    ((bf16_t*)(P.ws + WS_CAT))[(size_t)row * D + 256 + ch] = (bf16_t)f2bf(acc * P.in[19][l * GW + ch]);
}
__global__ void __launch_bounds__(256) k_gmlp_naive(Ptrs P, int l) {
    __shared__ float vln[128][65];
    const int chunk = blockIdx.x, g = blockIdx.y, tid = threadIdx.x, p = tid >> 1, hf = tid & 1;
    const int rowb = chunk * 128;
    const bf16_t* Z = (const bf16_t*)(P.ws + WS_Z) + (size_t)(rowb + p) * ZW;
    float v[32]; float s = 0.f;
#pragma unroll
    for (int c = 0; c < 32; ++c) { v[c] = bf2f(Z[ZC_GV + g * 64 + hf * 32 + c]); s += v[c]; }
    s += __shfl_xor(s, 1);
    const float mu = s * (1.f / 64.f); float q = 0.f;
#pragma unroll
    for (int c = 0; c < 32; ++c) { v[c] -= mu; q += v[c] * v[c]; }
    q += __shfl_xor(q, 1);
    const float rstd = rsqrtf(q * (1.f / 64.f) + LN_EPS);
#pragma unroll
    for (int c = 0; c < 32; ++c) { const int cc = g * 64 + hf * 32 + c; vln[p][hf * 32 + c] = v[c] * rstd * P.in[20][l * GW + cc] + P.in[21][l * GW + cc]; }
    __syncthreads();
    const float* ws = P.in[22] + ((size_t)(l * 4 + g) * 128 + p) * 128;
    float acc[32];
#pragma unroll
    for (int c = 0; c < 32; ++c) acc[c] = 0.f;
    for (int qq = 0; qq < 128; ++qq) { const float wv = ws[qq];
#pragma unroll
        for (int c = 0; c < 32; ++c) acc[c] += wv * vln[qq][hf * 32 + c]; }
    const float bs = P.in[23][(l * 4 + g) * 128 + p];
    bf16_t* o = (bf16_t*)(P.ws + WS_CAT) + (size_t)(rowb + p) * D + 512 + g * 64 + hf * 32;
#pragma unroll
    for (int c = 0; c < 32; ++c) o[c] = (bf16_t)f2bf(bf2f(Z[ZC_GU + g * 64 + hf * 32 + c]) * (acc[c] + bs));
}
__global__ void __launch_bounds__(256) k_ln(Ptrs P, const float* lg, const float* lb, int lA, int whichsh, int nrows) {
    const int row = blockIdx.x * 4 + (threadIdx.x >> 6), lane = threadIdx.x & 63;
    if (row >= nrows) return;
    float* xp = (row < MX) ? P.out + (size_t)row * D : (float*)(P.ws + WS_XSC) + (size_t)(row - MX) * D;
    f32x4 v[4]; float s = 0.f;
#pragma unroll
    for (int j = 0; j < 4; ++j) { v[j] = *(const f32x4*)(xp + j * 256 + lane * 4); s += (v[j][0] + v[j][1]) + (v[j][2] + v[j][3]); }
    const float mu = wave_sum(s) * (1.f / D); float q = 0.f;
#pragma unroll
    for (int j = 0; j < 4; ++j) { v[j] = v[j] - mu; q += (v[j][0] * v[j][0] + v[j][1] * v[j][1]) + (v[j][2] * v[j][2] + v[j][3] * v[j][3]); }
    const float rstd = rsqrtf(wave_sum(q) * (1.f / D) + LN_EPS);
    const float* MOD = (const float*)(P.ws + WS_MOD);
    const int cond = row_cond(row);
#pragma unroll
    for (int j = 0; j < 4; ++j) {
        const int c = j * 256 + lane * 4;
        const f32x4 o = v[j] * rstd * *(const f32x4*)(lg + c) + *(const f32x4*)(lb + c);
        *(f32x4*)(xp + c) = o;
        if (lA >= 0) {
            const f32x4 sh = *(const f32x4*)(modp(MOD, lA, cond, whichsh) + c), sc = *(const f32x4*)(modp(MOD, lA, cond, whichsh + 1) + c);
            const f32x4 hh = o * (sc + 1.0f) + sh;
            u32x2 w; w.x = pk2(hh[0], hh[1]); w.y = pk2(hh[2], hh[3]);
            *(u32x2*)((bf16_t*)(P.ws + WS_A) + (size_t)row * D + c) = w;
        }
    }
}

extern "C" void kernel_launch(void* const* d_in, const int* in_sizes, int n_in, void* d_out, int out_size, void* d_ws, size_t ws_size, hipStream_t stream) {
    if (n_in != 33 || ws_size < WS_END) { fprintf(stderr, "kernel_launch: unexpected n_in %d / ws_size %zu\n", n_in, ws_size); return; }
    Ptrs P{};
    for (int i = 0; i < 33; ++i) P.in[i] = (const float*)d_in[i];
    P.out = (float*)d_out; P.ws = (unsigned char*)d_ws;
    unsigned char* ws = P.ws;
    bf16_t* A = (bf16_t*)(ws + WS_A); bf16_t* Z = (bf16_t*)(ws + WS_Z); bf16_t* Cat = (bf16_t*)(ws + WS_CAT); bf16_t* H = (bf16_t*)(ws + WS_H);
    bf16_t* ZTX = (bf16_t*)(ws + WS_ZTX); bf16_t* ZTC = (bf16_t*)(ws + WS_ZTC);
    const float* MOD = (const float*)(ws + WS_MOD);
    hipLaunchKernelGGL(k_mod, dim3(6144 / 256, 17, 2), dim3(256), 0, stream, P);
    hipLaunchKernelGGL(k_pos, dim3(2048 * 1024 / 256), dim3(256), 0, stream, P);
    hipLaunchKernelGGL(k_wcs, dim3(2 * 4 * 2 * 64 * 64 / 256), dim3(256), 0, stream, P);
    hipLaunchKernelGGL(k_wf, dim3(2 * 2 * 4 * 1024 * 64 / 256), dim3(256), 0, stream, P);
    hipLaunchKernelGGL(k_dft, dim3((2048 * 4096 + 256 * 512) / 256), dim3(256), 0, stream, P);
    for (int l = 0; l < 2; ++l) {
        hipLaunchKernelGGL(k_wtrans, dim3(2048 / 32, 1024 / 32), dim3(256), 0, stream, P.in[6] + (size_t)l * D * INC, INC, (bf16_t*)(ws + WS_WIN) + (size_t)l * 2048 * 1024, 1024, 1);
        hipLaunchKernelGGL(k_wtrans, dim3(1024 / 32, 1024 / 32), dim3(256), 0, stream, P.in[26] + (size_t)l * D * D, D, (bf16_t*)(ws + WS_WOUT) + (size_t)l * D * D, 1024, 0);
        hipLaunchKernelGGL(k_wtrans, dim3(5632 / 32, 1024 / 32), dim3(256), 0, stream, P.in[31] + (size_t)l * D * 5632, 5632, (bf16_t*)(ws + WS_W1) + (size_t)l * 5632 * 1024, 1024, 2);
        hipLaunchKernelGGL(k_wtrans, dim3(1024 / 32, DFF / 32), dim3(256), 0, stream, P.in[32] + (size_t)l * DFF * D, D, (bf16_t*)(ws + WS_W2) + (size_t)l * D * DFF, DFF, 0);
    }
    hipLaunchKernelGGL(k_init, dim3(MT), dim3(256), 0, stream, P);
    for (int l = 0; l < 2; ++l) {
        const bool last = (l == 1);
        const int rows = last ? MX : MT;
        const bf16_t* WinT = (const bf16_t*)(ws + WS_WIN) + (size_t)l * 2048 * 1024;
        const bf16_t* WfT = (const bf16_t*)(ws + WS_WF) + (size_t)l * 512 * 1024;
        const bf16_t* WoT = (const bf16_t*)(ws + WS_WOUT) + (size_t)l * D * D;
        const bf16_t* W1T = (const bf16_t*)(ws + WS_W1) + (size_t)l * 5632 * 1024;
        const bf16_t* W2T = (const bf16_t*)(ws + WS_W2) + (size_t)l * D * DFF;
        hipLaunchKernelGGL(k_gemm<EpiInproj>, dim3(ZW / 256, rows / 128, 1), dim3(256), 0, stream, A, D, (size_t)0, WinT, D, (size_t)0, D, EpiInproj{Z, 0, 0});
        if (last) hipLaunchKernelGGL(k_gemm<EpiInproj>, dim3(1280 / 256, MC / 128, 1), dim3(256), 0, stream, A + (size_t)MX * D, D, (size_t)0, WinT, D, (size_t)0, D, EpiInproj{Z, MX, 0});
        hipLaunchKernelGGL(k_gemm<EpiFnetT>, dim3(rows / 256, 512 / 128, 1), dim3(256), 0, stream, WfT, D, (size_t)0, A, D, (size_t)0, D, EpiFnetT{ZTX, ZTC, 0, 0});
        hipLaunchKernelGGL(k_scan_naive, dim3(128), dim3(64), 0, stream, P, l);
        hipLaunchKernelGGL(k_readout_naive, dim3(rows), dim3(256), 0, stream, P, l, 0);
        hipLaunchKernelGGL(k_pool_naive, dim3(rows), dim3(256), 0, stream, P, l, 0);
        hipLaunchKernelGGL(k_gmlp_naive, dim3(rows / 128, 4), dim3(256), 0, stream, P, l);
        hipLaunchKernelGGL(k_gemm<EpiFourier>, dim3(1, SEQ / 128, NB), dim3(256), 0, stream, (const bf16_t*)(ws + WS_DFTX), 4096, (size_t)0, (const bf16_t*)ZTX, 4096, (size_t)256 * 4096, 4096, EpiFourier{Cat, P.in[25] + l * GW, 0, SEQ});
        if (!last) hipLaunchKernelGGL(k_gemm<EpiFourier>, dim3(1, CTXL / 128, NB), dim3(256), 0, stream, (const bf16_t*)(ws + WS_DFTC), 512, (size_t)0, (const bf16_t*)ZTC, 512, (size_t)256 * 512, 512, EpiFourier{Cat, P.in[25] + l * GW, MX, CTXL});
        hipLaunchKernelGGL(k_gemm<EpiRes>, dim3(D / 256, rows / 128, 1), dim3(256), 0, stream, (const bf16_t*)Cat, D, (size_t)0, WoT, D, (size_t)0, D, EpiRes{P.out, (float*)(ws + WS_XSC), MOD, l, 2});
        hipLaunchKernelGGL(k_ln, dim3(rows / 4), dim3(256), 0, stream, P, P.in[27] + l * D, P.in[28] + l * D, l, 3, rows);
        hipLaunchKernelGGL(k_gemm<EpiSwiglu>, dim3(5632 / 256, rows / 128, 1), dim3(256), 0, stream, (const bf16_t*)A, D, (size_t)0, W1T, D, (size_t)0, D, EpiSwiglu{H});
        hipLaunchKernelGGL(k_gemm<EpiRes>, dim3(D / 256, rows / 128, 1), dim3(256), 0, stream, (const bf16_t*)H, DFF, (size_t)0, W2T, DFF, (size_t)0, DFF, EpiRes{P.out, (float*)(ws + WS_XSC), MOD, l, 5});
        hipLaunchKernelGGL(k_ln, dim3(rows / 4), dim3(256), 0, stream, P, P.in[29] + l * D, P.in[30] + l * D, last ? -1 : l + 1, 0, rows);
    }
}
```

```cpp
#include <hip/hip_runtime.h>
#include <cstdint>
#include <cstdio>

constexpr int D = 1024, NB = 16, SEQ = 2048, CTXL = 256;
constexpr int MX = NB * SEQ;
constexpr int MC = NB * CTXL;
constexpr int MT = MX + MC;
constexpr int GW = 256;
constexpr int INC = 2176;
constexpr int ZW = 2048;
constexpr int DFF = 2816;
constexpr float ALPHA = 1.4142135623730951f;
constexpr float LN_EPS = 1e-5f, GN_EPS = 64e-5f;
constexpr int ZC_R = 0, ZC_K = 256, ZC_V = 512, ZC_DW = 768, ZC_DA = 896, ZC_DG = 1024, ZC_POOL = 1280, ZC_GU = 1536, ZC_GV = 1792;

constexpr size_t MiB = 1u << 20;
constexpr size_t WS_CTL = 0, CTL_ZERO_BYTES = 256 * 1024;
constexpr size_t WS_MOD = 1 * MiB;
constexpr size_t WS_WCS = 2 * MiB;
constexpr size_t WS_POS = 10 * MiB;
constexpr size_t WS_WIN = 18 * MiB;
constexpr size_t WS_WF = 26 * MiB;
constexpr size_t WS_WOUT = 28 * MiB;
constexpr size_t WS_W1 = 32 * MiB;
constexpr size_t WS_W2 = 54 * MiB;
constexpr size_t WS_DFTX = 65 * MiB;
constexpr size_t WS_DFTC = 81 * MiB;
constexpr size_t WS_XSC = 82 * MiB;
constexpr size_t WS_A = 98 * MiB;
constexpr size_t WS_Z = 170 * MiB;
constexpr size_t WS_CAT = 314 * MiB;
constexpr size_t WS_H = 170 * MiB;
constexpr size_t WS_ZTX = 386 * MiB;
constexpr size_t WS_ZTC = 418 * MiB;
constexpr size_t WS_Y = 422 * MiB;
constexpr size_t WS_BS = 458 * MiB;
constexpr size_t WS_END = 460 * MiB;
constexpr int CW_BAR = 4096;

#define GAS __attribute__((address_space(1)))
#define LAS __attribute__((address_space(3)))
typedef GAS unsigned gu32;
#define RLX_AGENT __ATOMIC_RELAXED, __HIP_MEMORY_SCOPE_AGENT
#define LDS_WAIT() asm volatile("s_waitcnt lgkmcnt(0)" ::: "memory")
#define VM_WAIT() asm volatile("s_waitcnt vmcnt(0)" ::: "memory")

__device__ __forceinline__ unsigned f2bf(float f) { unsigned u = __builtin_bit_cast(unsigned, f); return (u + 0x7fffu + ((u >> 16) & 1u)) >> 16; }
__device__ __forceinline__ unsigned pk2(float lo, float hi) { return f2bf(lo) | (f2bf(hi) << 16); }

namespace pg8 {
#define PG8_LAS __attribute__((address_space(3)))
typedef unsigned short bf16_t;
typedef short bf16x8 __attribute__((ext_vector_type(8)));
typedef float f32x4 __attribute__((ext_vector_type(4)));
typedef unsigned u32x4 __attribute__((ext_vector_type(4)));
constexpr int BM = 256, BK = 64, HALF = 128, HTB = HALF * BK * 2  , STAGE_BYTES = 8 * HTB, NXCD = 8, WGM = 8;

__host__ __device__ __forceinline__ int lds_byte(int r, int c) { const int st = (r >> 4) * 2 + (c >> 5), rr = r & 15, cc = c & 31, ob = rr * 64 + cc * 2; return st * 1024 + (ob ^ (((ob >> 9) & 1) << 5)); }
__host__ __device__ __forceinline__ void stage_rc(int b, int& R, int& C) { const int st = b / 1024, sb = b % 1024, swz = sb ^ (((sb >> 9) & 1) << 5); R = (st >> 1) * 16 + swz / 64; C = (st & 1) * 32 + (swz % 64) / 2; }
__host__ __device__ __forceinline__ int perm32(int rho) { const int n = rho >> 4, i = rho & 15; return 8 * (i >> 2) + 4 * n + (i & 3); }

struct Unit { int pm, pn; };
struct Gemm { const bf16_t* A; const bf16_t* Bt; int M, N, K; };

struct StaticOrder {
    int nM, nN, nwg, G, c;
    __host__ __device__ void init(int M, int N, int G_, int c_) { nM = M / BM; nN = N / BM; nwg = nM * nN; G = G_; c = c_; }
    __host__ __device__ bool next(int i, Unit& u) const {
        const long L = (long)i * G + c; if (L >= nwg) return false;
        int wgid = (int)L; { const int q = nwg / NXCD, r = nwg % NXCD, xcd = wgid % NXCD, off = wgid / NXCD; wgid = (xcd < r ? xcd * (q + 1) : r * (q + 1) + (xcd - r) * q) + off; }
        const int nig = WGM * nN, gid = wgid / nig, fm = gid * WGM, gsz = (nM - fm) < WGM ? (nM - fm) : WGM;
        u.pm = fm + ((wgid % nig) % gsz); u.pn = (wgid % nig) / gsz; return true;
    }
    __device__ __forceinline__ void a_ready(const Unit&) const {}
    __device__ __forceinline__ void done(const Unit&) const {}
};


__device__ __forceinline__ void tile_map(int wgid, int nM, int nN, int& pm, int& pn) {
    const int nwg = nM * nN;
    { const int q = nwg / NXCD, r = nwg % NXCD, xcd = wgid % NXCD, off = wgid / NXCD; wgid = (xcd < r ? xcd * (q + 1) : r * (q + 1) + (xcd - r) * q) + off; }
    const int nig = WGM * nN, gid = wgid / nig, fm = gid * WGM, gsz = (nM - fm) < WGM ? (nM - fm) : WGM;
    pm = fm + ((wgid % nig) % gsz); pn = (wgid % nig) / gsz;
}
struct Order2 {
    int nM0, nN0, nM1, nN1, G, c;
    __device__ __forceinline__ bool next(int i, Unit& u) const {
        const int n0 = nM0 * nN0, n1 = nM1 * nN1; const long L = (long)i * G + c; if (L >= n0 + n1) return false;
        if (L < n0) tile_map((int)L, nM0, nN0, u.pm, u.pn); else { tile_map((int)L - n0, nM1, nN1, u.pm, u.pn); u.pm += nM0; }
        return true;
    }
    __device__ __forceinline__ void a_ready(const Unit&) const {}
    __device__ __forceinline__ void done(const Unit&) const {}
};

__device__ __forceinline__ unsigned cvt_pk_bf16(float lo, float hi) { unsigned r; asm volatile("v_cvt_pk_bf16_f32 %0, %1, %2" : "=v"(r) : "v"(lo), "v"(hi)); return r; }
__device__ __forceinline__ float fsig(float y) { return __builtin_amdgcn_rcpf(1.0f + __builtin_amdgcn_exp2f(-1.4426950408889634f * y)); }
__device__ __forceinline__ float fact(float x, int kind) {
    if (kind == 1) return 2.0f * fsig(2.0f * x) - 1.0f;
    if (kind == 2) return fsig(x);
    if (kind == 3) return x * fsig(1.5957691216057308f * (x + 0.044715f * x * x * x));
    return x;
}
struct EpiZ {
    static constexpr bool PERM = true, AFTER_DRAIN = false;
    bf16_t* Z;
    __device__ __forceinline__ void operator()(const f32x4 (&acc)[2][2][4][2], const Unit& u, int wr, int wc, int fr, int fq) const {
        const int row0 = u.pm * BM + wr * 64 + fr, col0 = u.pn * BM + wc * 32 + 8 * fq;
        int kind[2] = {0, 0};
        if (u.pn == 3) kind[0] = 1; else if (u.pn == 4) kind[0] = 2; else if (u.pn >= 6) { kind[0] = 3; kind[1] = 3; }
#pragma unroll
        for (int ai = 0; ai < 2; ++ai)
#pragma unroll
            for (int m = 0; m < 4; ++m) { bf16_t* rowp = Z + (size_t)(row0 + ai * HALF + m * 16) * ZW + col0;
#pragma unroll
                for (int bj = 0; bj < 2; ++bj) { f32x4 v0 = acc[ai][bj][m][0], v1 = acc[ai][bj][m][1]; const int kd = kind[bj];
                    if (kd) {
#pragma unroll
                        for (int e = 0; e < 4; ++e) { v0[e] = fact(v0[e], kd); v1[e] = fact(v1[e], kd); } }
                    u32x4 w; w.x = cvt_pk_bf16(v0[0], v0[1]); w.y = cvt_pk_bf16(v0[2], v0[3]); w.z = cvt_pk_bf16(v1[0], v1[1]); w.w = cvt_pk_bf16(v1[2], v1[3]);
                    *(u32x4*)(rowp + bj * HALF) = w; } }
    }
};
struct EpiZT {
    static constexpr bool PERM = true, AFTER_DRAIN = false;
    bf16_t* ZTX; bf16_t* ZTC;
    __device__ __forceinline__ void operator()(const f32x4 (&acc)[2][2][4][2], const Unit& u, int wr, int wc, int fr, int fq) const {
        const int tok0 = u.pn * BM, s = u.pm; bf16_t* base; int ld;
        if (tok0 < MX) { const int b = tok0 >> 11, t0 = tok0 & 2047; base = ZTX + (size_t)(b * 256) * 4096 + s * 2048 + t0; ld = 4096; }
        else { const int b = (tok0 - MX) >> 8; base = ZTC + (size_t)(b * 256) * 512 + s * 256; ld = 512; }
        const int n0 = wr * 64 + fr, c0 = wc * 32 + 8 * fq;
#pragma unroll
        for (int ai = 0; ai < 2; ++ai)
#pragma unroll
            for (int m = 0; m < 4; ++m) { bf16_t* rowp = base + (size_t)(n0 + ai * HALF + m * 16) * ld + c0;
#pragma unroll
                for (int bj = 0; bj < 2; ++bj) { const f32x4 v0 = acc[ai][bj][m][0], v1 = acc[ai][bj][m][1];
                    u32x4 w; w.x = cvt_pk_bf16(v0[0], v0[1]); w.y = cvt_pk_bf16(v0[2], v0[3]); w.z = cvt_pk_bf16(v1[0], v1[1]); w.w = cvt_pk_bf16(v1[2], v1[3]);
                    *(u32x4*)(rowp + bj * HALF) = w; } }
    }
};
struct EpiFourier {
    static constexpr bool PERM = true, AFTER_DRAIN = false;
    bf16_t* Cat; const float* fb; int rowbase, Ls;
    __device__ __forceinline__ void operator()(const f32x4 (&acc)[2][2][4][2], const Unit& u, int wr, int wc, int fr, int fq) const {
        const int row0 = rowbase + u.pn * Ls + u.pm * BM + wr * 64 + fr, c0 = wc * 32 + 8 * fq;
        f32x4 bv[2][2];
#pragma unroll
        for (int bj = 0; bj < 2; ++bj)
#pragma unroll
            for (int n = 0; n < 2; ++n) bv[bj][n] = *(const f32x4*)(fb + c0 + bj * HALF + 4 * n);
#pragma unroll
        for (int ai = 0; ai < 2; ++ai)
#pragma unroll
            for (int m = 0; m < 4; ++m) { bf16_t* rowp = Cat + (size_t)(row0 + ai * HALF + m * 16) * D + 768 + c0;
#pragma unroll
                for (int bj = 0; bj < 2; ++bj) { const f32x4 v0 = acc[ai][bj][m][0] + bv[bj][0], v1 = acc[ai][bj][m][1] + bv[bj][1];
                    u32x4 w; w.x = cvt_pk_bf16(v0[0], v0[1]); w.y = cvt_pk_bf16(v0[2], v0[3]); w.z = cvt_pk_bf16(v1[0], v1[1]); w.w = cvt_pk_bf16(v1[2], v1[3]);
                    *(u32x4*)(rowp + bj * HALF) = w; } }
    }
};
struct EpiRes {
    static constexpr bool PERM = false, AFTER_DRAIN = false;
    float* out; float* xsc; const float* gmod;
    __device__ __forceinline__ void operator()(const f32x4 (&acc)[2][2][4][2], const Unit& u, int wr, int wc, int fr, int fq) const {
        const int prow = u.pm * BM; const bool isx = prow < MX;
        float* base = isx ? out + (size_t)prow * D : xsc + (size_t)(prow - MX) * D;
        const float* g = gmod + (size_t)(isx ? (prow >> 11) : 16) * 6144;
        const int col0 = u.pn * BM + wc * 32 + 4 * fq;
        f32x4 gv[2][2];
#pragma unroll
        for (int bj = 0; bj < 2; ++bj)
#pragma unroll
            for (int n = 0; n < 2; ++n) gv[bj][n] = *(const f32x4*)(g + col0 + bj * HALF + n * 16);
#pragma unroll
        for (int ai = 0; ai < 2; ++ai)
#pragma unroll
            for (int m = 0; m < 4; ++m) { float* rowp = base + (size_t)(ai * HALF + wr * 64 + m * 16 + fr) * D + col0;
#pragma unroll
                for (int bj = 0; bj < 2; ++bj)
#pragma unroll
                    for (int n = 0; n < 2; ++n) { float* p = rowp + bj * HALF + n * 16; const f32x4 x = *(const f32x4*)p; *(f32x4*)p = x * ALPHA + gv[bj][n] * acc[ai][bj][m][n]; } }
    }
};
struct EpiSwiglu {
    static constexpr bool PERM = true, AFTER_DRAIN = false;
    bf16_t* H;
    __device__ __forceinline__ void operator()(const f32x4 (&acc)[2][2][4][2], const Unit& u, int wr, int wc, int fr, int fq) const {
        const int row0 = u.pm * BM + wr * 64 + fr, col0 = u.pn * HALF + wc * 32 + 8 * fq;
#pragma unroll
        for (int ai = 0; ai < 2; ++ai)
#pragma unroll
            for (int m = 0; m < 4; ++m) { f32x4 h0, h1; const f32x4 g0 = acc[ai][0][m][0], g1 = acc[ai][0][m][1], u0 = acc[ai][1][m][0], u1 = acc[ai][1][m][1];
#pragma unroll
                for (int e = 0; e < 4; ++e) { h0[e] = g0[e] * fsig(g0[e]) * u0[e]; h1[e] = g1[e] * fsig(g1[e]) * u1[e]; }
                u32x4 w; w.x = cvt_pk_bf16(h0[0], h0[1]); w.y = cvt_pk_bf16(h0[2], h0[3]); w.z = cvt_pk_bf16(h1[0], h1[1]); w.w = cvt_pk_bf16(h1[2], h1[3]);
                *(u32x4*)(H + (size_t)(row0 + ai * HALF + m * 16) * DFF + col0) = w; }
    }
};

template <class Epi, class Sched, bool ALIGN_EPI = false, bool SP2 = false>
__device__ __forceinline__ void gemm_phase(PG8_LAS unsigned char* lds, const Gemm g, const Sched& S, const Epi& E) {
    int tid_ = threadIdx.x; asm volatile("" : "+v"(tid_));
    const int tid = tid_, wid = __builtin_amdgcn_readfirstlane(tid >> 6), lane = tid & 63, wr = wid >> 2, wc = wid & 3, fr = lane & 15, fq = lane >> 4;
    const int K = g.K, nt = K / BK;
    unsigned voffA[2], voffB[2];
#pragma unroll
    for (int i = 0; i < 2; ++i) { int R, C; stage_rc(tid * 16 + i * 8192, R, C); const int Rb = Epi::PERM ? ((R & ~31) + perm32(R & 31)) : R;
        voffA[i] = (unsigned)(R * K + C) * 2u; voffB[i] = (unsigned)(Rb * K + C) * 2u; }
    const size_t kstep = (size_t)(BK * 2);
    const size_t hstep = (size_t)HALF * K * 2;
    const size_t tstep = 2 * hstep;
    const unsigned ldsw = (unsigned)wid * 1024u;
    const int aoff = lds_byte(wr * 64 + fr, fq * 8), boff = lds_byte(wc * 32 + fr, fq * 8);
#define PG8_SA(b, h) (((b) * 2 + (h)) * HTB)
#define PG8_SB(b, h) ((4 + (b) * 2 + (h)) * HTB)
#define PG8_STAGE(bufoff, gbase, voff) do { _Pragma("unroll") for (int _i = 0; _i < 2; ++_i) \
        __builtin_amdgcn_global_load_lds((const unsigned*)((const char*)(gbase) + (voff)[_i]), (PG8_LAS unsigned*)(lds + (bufoff) + ldsw + _i * 8192), 16, 0, 0); } while (0)
#define PG8_LDA(dst, b, h) do { _Pragma("unroll") for (int m = 0; m < 4; ++m) _Pragma("unroll") for (int k = 0; k < 2; ++k) dst[m][k] = *(const PG8_LAS bf16x8*)(lds + PG8_SA(b, h) + aoff + m * 2048 + k * 1024); } while (0)
#define PG8_LDB(dst, b, h) do { _Pragma("unroll") for (int n = 0; n < 2; ++n) _Pragma("unroll") for (int k = 0; k < 2; ++k) dst[n][k] = *(const PG8_LAS bf16x8*)(lds + PG8_SB(b, h) + boff + n * 2048 + k * 1024); } while (0)
#define PG8_MMA(ai, bj, At, Bt) do { __builtin_amdgcn_s_setprio(1); _Pragma("unroll") for (int m = 0; m < 4; ++m) _Pragma("unroll") for (int n = 0; n < 2; ++n) _Pragma("unroll") for (int k = 0; k < 2; ++k) \
        acc[ai][bj][m][n] = __builtin_amdgcn_mfma_f32_16x16x32_bf16(Bt[n][k], At[m][k], acc[ai][bj][m][n], 0, 0, 0); __builtin_amdgcn_s_setprio(0); } while (0)
#define PG8_WAIT_V(n) asm volatile("s_waitcnt vmcnt(" #n ")" ::: "memory")
#define PG8_WAIT_L(n) asm volatile("s_waitcnt lgkmcnt(" #n ")" ::: "memory")
#define PG8_BAR __builtin_amdgcn_s_barrier()
#define PG8_SCHED __builtin_amdgcn_sched_barrier(0)
    Unit cur, nxt; int ui = 0;
    if (!S.next(0, cur)) return;
    f32x4 acc[2][2][4][2];
#pragma unroll
    for (int a = 0; a < 2; ++a)
#pragma unroll
        for (int b = 0; b < 2; ++b)
#pragma unroll
            for (int m = 0; m < 4; ++m)
#pragma unroll
                for (int n = 0; n < 2; ++n) acc[a][b][m][n] = (f32x4){0.f, 0.f, 0.f, 0.f};
    bf16x8 At[4][2], B0[2][2], B1[2][2];
    const char* cA = (const char*)g.A + (size_t)cur.pm * tstep; const char* cB = (const char*)g.Bt + (size_t)cur.pn * tstep;
    S.a_ready(cur);
    if constexpr (SP2) {
        PG8_STAGE(PG8_SB(0, 0), cB, voffB); PG8_STAGE(PG8_SB(0, 1), cB + hstep, voffB); PG8_STAGE(PG8_SA(0, 0), cA, voffA); PG8_STAGE(PG8_SA(0, 1), cA + hstep, voffA);
        if (wr == 1) PG8_BAR;
        PG8_WAIT_V(2); PG8_BAR;
        PG8_STAGE(PG8_SB(1, 0), cB + kstep, voffB); PG8_STAGE(PG8_SA(1, 0), cA + kstep, voffA); PG8_STAGE(PG8_SB(1, 1), cB + hstep + kstep, voffB);
        PG8_WAIT_V(6); PG8_BAR;
    } else {
        PG8_STAGE(PG8_SB(0, 0), cB, voffB); PG8_STAGE(PG8_SA(0, 0), cA, voffA); PG8_STAGE(PG8_SB(0, 1), cB + hstep, voffB); PG8_STAGE(PG8_SA(0, 1), cA + hstep, voffA);
        if (wr == 1) PG8_BAR;
        PG8_WAIT_V(4); PG8_BAR;
        PG8_STAGE(PG8_SB(1, 0), cB + kstep, voffB); PG8_STAGE(PG8_SA(1, 0), cA + kstep, voffA); PG8_STAGE(PG8_SB(1, 1), cB + hstep + kstep, voffB);
        PG8_WAIT_V(6); PG8_BAR;
    }
    for (;;) {
        const bool has_next = S.next(ui + 1, nxt);
        const char* nA = has_next ? (const char*)g.A + (size_t)nxt.pm * tstep : cA; const char* nB = has_next ? (const char*)g.Bt + (size_t)nxt.pn * tstep : cB;
        for (int t = 0; t < nt; t += 2) {
            const bool last = (t == nt - 2);
            const char* a1 = cA + (size_t)(t + 1) * kstep;
            const char* a2 = last ? nA : cA + (size_t)(t + 2) * kstep; const char* b2 = last ? nB : cB + (size_t)(t + 2) * kstep;
            const char* a3 = a2 + kstep; const char* b3 = b2 + kstep;
            if (last && has_next) S.a_ready(nxt);
            if constexpr (SP2) {
            PG8_LDB(B0, 0, 0); PG8_LDB(B1, 0, 1); PG8_SCHED; PG8_LDA(At, 0, 0); PG8_STAGE(PG8_SA(1, 1), a1 + hstep, voffA);
            PG8_WAIT_V(8); PG8_WAIT_L(0); PG8_BAR; PG8_MMA(0, 0, At, B0); PG8_MMA(0, 1, At, B1); PG8_BAR; PG8_SCHED;
            PG8_LDA(At, 0, 1); PG8_STAGE(PG8_SB(0, 0), b2, voffB); PG8_STAGE(PG8_SB(0, 1), b2 + hstep, voffB); PG8_STAGE(PG8_SA(0, 0), a2, voffA);
            PG8_WAIT_V(8); PG8_WAIT_L(0); PG8_BAR; PG8_MMA(1, 0, At, B0); PG8_MMA(1, 1, At, B1); PG8_BAR; PG8_SCHED;
            PG8_LDB(B0, 1, 0); PG8_LDB(B1, 1, 1); PG8_SCHED; PG8_LDA(At, 1, 0); PG8_STAGE(PG8_SA(0, 1), a2 + hstep, voffA);
            PG8_WAIT_V(8); PG8_WAIT_L(0); PG8_BAR; PG8_MMA(0, 0, At, B0); PG8_MMA(0, 1, At, B1); PG8_BAR; PG8_SCHED;
            PG8_LDA(At, 1, 1); PG8_STAGE(PG8_SB(1, 0), b3, voffB); PG8_STAGE(PG8_SB(1, 1), b3 + hstep, voffB); PG8_STAGE(PG8_SA(1, 0), a3, voffA);
            PG8_WAIT_V(8); PG8_WAIT_L(0); PG8_BAR; PG8_MMA(1, 0, At, B0); PG8_MMA(1, 1, At, B1); PG8_BAR; PG8_SCHED;
            } else {
            PG8_LDB(B0, 0, 0); PG8_SCHED; PG8_LDA(At, 0, 0); PG8_STAGE(PG8_SA(1, 1), a1 + hstep, voffA);
            PG8_WAIT_L(8); PG8_BAR; PG8_WAIT_L(0); PG8_MMA(0, 0, At, B0); PG8_BAR; PG8_SCHED;
            PG8_LDB(B1, 0, 1); PG8_STAGE(PG8_SB(0, 0), b2, voffB);
            PG8_BAR; PG8_WAIT_L(0); PG8_MMA(0, 1, At, B1); PG8_BAR;
            PG8_LDA(At, 0, 1); PG8_STAGE(PG8_SA(0, 0), a2, voffA);
            PG8_BAR; PG8_WAIT_L(0); PG8_MMA(1, 0, At, B0); PG8_BAR; PG8_SCHED;
            PG8_STAGE(PG8_SB(0, 1), b2 + hstep, voffB);
            PG8_WAIT_V(6); PG8_BAR; PG8_MMA(1, 1, At, B1); PG8_BAR;
            PG8_LDB(B0, 1, 0); PG8_SCHED; PG8_LDA(At, 1, 0); PG8_STAGE(PG8_SA(0, 1), a2 + hstep, voffA);
            PG8_WAIT_L(8); PG8_BAR; PG8_WAIT_L(0); PG8_MMA(0, 0, At, B0); PG8_BAR; PG8_SCHED;
            PG8_LDB(B1, 1, 1); PG8_STAGE(PG8_SB(1, 0), b3, voffB);
            PG8_BAR; PG8_WAIT_L(0); PG8_MMA(0, 1, At, B1); PG8_BAR;
            PG8_LDA(At, 1, 1); PG8_STAGE(PG8_SA(1, 0), a3, voffA);
            PG8_BAR; PG8_WAIT_L(0); PG8_MMA(1, 0, At, B0); PG8_BAR; PG8_SCHED;
            PG8_STAGE(PG8_SB(1, 1), b3 + hstep, voffB);
            PG8_WAIT_V(6); PG8_BAR; PG8_MMA(1, 1, At, B1); PG8_BAR;
            }
        }
        if constexpr (ALIGN_EPI) { if (wr == 0) PG8_BAR; }
        if constexpr (!Epi::AFTER_DRAIN) { E(acc, cur, wr, wc, fr, fq); S.done(cur); }
        if (!has_next) break;
#pragma unroll
        for (int a = 0; a < 2; ++a)
#pragma unroll
            for (int b = 0; b < 2; ++b)
#pragma unroll
                for (int m = 0; m < 4; ++m)
#pragma unroll
                    for (int n = 0; n < 2; ++n) acc[a][b][m][n] = (f32x4){0.f, 0.f, 0.f, 0.f};
        cur = nxt; cA = nA; cB = nB; ++ui;
        if constexpr (ALIGN_EPI) { if (wr == 1) PG8_BAR; }
    }
    PG8_WAIT_V(0);
    if constexpr (!ALIGN_EPI) { if (wr == 0) PG8_BAR; }
    PG8_BAR;
    if constexpr (Epi::AFTER_DRAIN) { E.fused(acc, cur, wr, wc, fr, fq, lds, wid, lane); S.done(cur); }
#undef PG8_SA
#undef PG8_SB
#undef PG8_STAGE
#undef PG8_LDA
#undef PG8_LDB
#undef PG8_MMA
#undef PG8_WAIT_V
#undef PG8_WAIT_L
#undef PG8_BAR
#undef PG8_SCHED
}
}

#define XB_TMO      128
#define XB_XCNT(j)  (256  + 64 * (j))
#define XB_XSUB(j)  (1280 + 64 * (j))
#define XB_XGEN(j)  (2304 + 64 * (j))
#define XB_TOP      3328
#define XB_TOPGEN   3392
#define XCD_BAR_WORDS 3456
#define XB_SPIN_CAP (1u << 18)

__device__ __forceinline__ unsigned xb_ld(unsigned* p)              { return __hip_atomic_load(p, __ATOMIC_RELAXED, __HIP_MEMORY_SCOPE_AGENT); }
__device__ __forceinline__ unsigned xb_add(unsigned* p, unsigned v) { return __hip_atomic_fetch_add(p, v, __ATOMIC_RELAXED, __HIP_MEMORY_SCOPE_AGENT); }
__device__ __forceinline__ unsigned xb_xcc_id() { return (unsigned)__builtin_amdgcn_s_getreg((3 << 11) | 20) & 0xFu; }
#define XB_SPIN(cond, bar) do { unsigned _sp = 0; while (cond) { __builtin_amdgcn_s_sleep(1); \
    if ((++_sp & 255u) == 0u) { if (xb_ld(&(bar)[XB_TMO])) break; if (_sp > XB_SPIN_CAP) { atomicAdd(&(bar)[XB_TMO], 1u); break; } } } } while (0)

struct XcdBarrier {
    unsigned* bar; unsigned x;
    volatile LAS unsigned* st;
};

__device__ __forceinline__ XcdBarrier xcd_barrier_post(unsigned* bar, volatile LAS unsigned* st) {
    XcdBarrier b; b.bar = bar; b.x = xb_xcc_id(); b.st = st;
    if (threadIdx.x == 0) (void)xb_add(&bar[XB_XCNT(b.x)], 1u);
    return b;
}
__device__ __forceinline__ void xcd_barrier_complete(unsigned* bar, unsigned x, unsigned& nloc, unsigned& nx) {
    const unsigned G = gridDim.x * gridDim.y * gridDim.z;
    unsigned sum, cnt, mine, sp = 0u;
    for (;;) {
        sum = 0u; cnt = 0u; mine = 0u;
#pragma unroll
        for (unsigned j = 0; j < 16; ++j) { const unsigned c = xb_ld(&bar[XB_XCNT(j)]); sum += c; cnt += (c > 0u) ? 1u : 0u; mine = (j == x) ? c : mine; }
        if (sum == G) break;
        __builtin_amdgcn_s_sleep(1);
        if ((++sp & 255u) == 0u) { if (xb_ld(&bar[XB_TMO])) break; if (sp > XB_SPIN_CAP) { atomicAdd(&bar[XB_TMO], 1u); break; } }
    }
    nloc = mine > 0u ? mine : 1u; nx = cnt > 0u ? cnt : 1u;
}

__device__ __forceinline__ void xcd_barrier(const XcdBarrier& b) {
    asm volatile("s_waitcnt vmcnt(0)" ::: "memory");
    __syncthreads();
    if (threadIdx.x == 0) {
        unsigned* bar = b.bar;
        __builtin_amdgcn_s_waitcnt(0);
        unsigned nloc = b.st[0], nx = b.st[1];
        if (nloc == 0u) { xcd_barrier_complete(bar, b.x, nloc, nx); b.st[0] = nloc; b.st[1] = nx; }
        const unsigned old = xb_add(&bar[XB_XSUB(b.x)], 1u);
        const unsigned gen = old / nloc;
        if (old + 1u == (gen + 1u) * nloc) {
            __builtin_amdgcn_fence(__ATOMIC_RELEASE, "agent");
            asm volatile("s_waitcnt vmcnt(0)" ::: "memory");
            const unsigned og = xb_add(&bar[XB_TOP], 1u);
            const unsigned tg = og / nx;
            if (og + 1u == (tg + 1u) * nx) xb_add(&bar[XB_TOPGEN], 1u);
            else XB_SPIN(xb_ld(&bar[XB_TOPGEN]) == tg, bar);
            __builtin_amdgcn_fence(__ATOMIC_ACQUIRE, "agent");
            xb_add(&bar[XB_XGEN(b.x)], 1u);
            asm volatile("s_waitcnt vmcnt(0)" ::: "memory");
        } else {
            XB_SPIN(xb_ld(&bar[XB_XGEN(b.x)]) == gen, bar);
            __builtin_amdgcn_fence(__ATOMIC_ACQUIRE, "agent");
            asm volatile("s_waitcnt vmcnt(0)" ::: "memory");
        }
    }
    __syncthreads();
}

typedef pg8::bf16_t bf16_t;
typedef pg8::f32x4 f32x4;
typedef unsigned u32x2 __attribute__((ext_vector_type(2)));
typedef unsigned u32x4 __attribute__((ext_vector_type(4)));
constexpr int NWAVES = 8, NTHR = 512;
constexpr int RING_BYTES = 131072, LDSCTL_OFF = RING_BYTES, MISC_OFF = LDSCTL_OFF + 320, LDS_BYTES = 147456;
constexpr int NPHASE = 18;

struct Args { const float* in[33]; float* out; unsigned char* ws; int ph_lo, ph_hi, li, pad; };

__device__ __forceinline__ float bf2f(bf16_t h) { return __uint_as_float(((unsigned)h) << 16); }
__device__ __forceinline__ float sigmoidf_(float x) { return 1.f / (1.f + __expf(-x)); }
__device__ __forceinline__ float siluf_(float x) { return x / (1.f + __expf(-x)); }
__device__ __forceinline__ float wave_sum(float v) {
#pragma unroll
    for (int o = 1; o < 64; o <<= 1) v += __shfl_xor(v, o);
    return v;
}
__device__ __forceinline__ int row_cond(int r) { return r < MX ? (r >> 11) : 16; }
__device__ __forceinline__ const float* modp(const float* MOD, int l, int cond, int which) { return MOD + ((size_t)(l * 17 + cond) * 6 + which) * 1024; }

__device__ __forceinline__ void ph_mod(const Args& a, LAS unsigned char* lds, int tid) {
    asm volatile("" : "+v"(tid));
    LAS float* ssilu = (LAS float*)lds;
    LAS float* part = (LAS float*)(lds + 69632);
    const int lane = tid & 63, w = tid >> 6;
    if (blockIdx.x < 192) {
        for (int idx = tid; idx < 17 * 1024; idx += NTHR) { const int r = idx >> 10, k = idx & 1023; const float c = (r < 16) ? a.in[1][r * D + k] : a.in[3][k]; ssilu[idx] = siluf_(c); }
    }
    __syncthreads();
    float* MOD = (float*)(a.ws + WS_MOD);
    for (int item = blockIdx.x; item < 192; item += gridDim.x) {
        const int l = item / 96, cb = item % 96;
        const float* wm = a.in[4] + (size_t)l * D * 6144 + cb * 64 + lane;
        float acc[17];
#pragma unroll
        for (int r = 0; r < 17; ++r) acc[r] = 0.f;
        for (int k = w * 128; k < w * 128 + 128; ++k) { const float wv = wm[(size_t)k * 6144];
#pragma unroll
            for (int r = 0; r < 17; ++r) acc[r] += ssilu[r * 1024 + k] * wv; }
#pragma unroll
        for (int r = 0; r < 17; ++r) part[(w * 17 + r) * 64 + lane] = acc[r];
        __syncthreads();
        for (int o = tid; o < 17 * 64; o += NTHR) { const int r = o >> 6, col = o & 63; float s = a.in[5][l * 6144 + cb * 64 + col];
#pragma unroll
            for (int w2 = 0; w2 < 8; ++w2) s += part[(w2 * 17 + r) * 64 + col];
            MOD[(size_t)(l * 17 + r) * 6144 + cb * 64 + col] = s; }
        __syncthreads();
    }
}
__device__ __forceinline__ void ph_tables(const Args& a, int tid) {
    asm volatile("" : "+v"(tid));
    const size_t gtid = (size_t)blockIdx.x * NTHR + tid, gsz = (size_t)gridDim.x * NTHR;
    float* POS = (float*)(a.ws + WS_POS);
    for (size_t idx = gtid; idx < (size_t)SEQ * D; idx += gsz) {
        const int t = (int)(idx >> 10), ch = (int)(idx & 1023), q = ch >> 8, i = ch & 255;
        const float f = expf(-9.210340371976184f * (float)i / 256.0f);
        const float p = (q < 2) ? (float)(t >> 6) : (float)(t & 63);
        const float ang = p * f;
        POS[idx] = (q & 1) ? cosf(ang) : sinf(ang);
    }
    bf16_t* DX = (bf16_t*)(a.ws + WS_DFTX); bf16_t* DC = (bf16_t*)(a.ws + WS_DFTC);
    for (size_t idx = gtid; idx < (size_t)2048 * 4096 + 256 * 512; idx += gsz) {
        if (idx < (size_t)2048 * 4096) {
            const int k = (int)(idx >> 12), kk = (int)(idx & 4095), t = kk & 2047, ii = (k * t) & 2047;
            const float v = (kk < 2048) ? cospif((float)ii / 1024.f) : -sinpif((float)ii / 1024.f);
            DX[idx] = (bf16_t)f2bf(v * 0.022097086912079608f);
        } else {
            const int j = (int)(idx - (size_t)2048 * 4096), k = j >> 9, kk = j & 511, t = kk & 255, ii = (k * t) & 255;
            const float v = (kk < 256) ? cospif((float)ii / 128.f) : -sinpif((float)ii / 128.f);
            DC[j] = (bf16_t)f2bf(v * 0.0625f);
        }
    }
    float* WCS = (float*)(a.ws + WS_WCS);
    for (size_t idx = gtid; idx < 65536; idx += gsz) {
        const int i = (int)idx, d = i & 63, c = (i >> 6) & 63, s = (i >> 12) & 1, g = (i >> 13) & 3, l = i >> 15;
        const float* fw = a.in[24] + (size_t)(l * 4 + g) * 4096;
        float acc = 0.f;
        for (int m = 0; m < 64; ++m) { const int ii = (m * c) & 63; const float tr = s ? sinpif((float)ii / 32.f) : cospif((float)ii / 32.f); acc += tr * fw[m * 64 + d]; }
        WCS[i] = acc * 0.125f;
    }
}
__device__ __forceinline__ int colmap(int n, int mode) {
    if (mode == 0) return n;
    if (mode == 1) { if (n < 1152) return n; if (n < 1280) return -1; return n - 128; }
    const int tile = n >> 8, half = (n >> 7) & 1, j = n & 127; return half * DFF + tile * 128 + j;
}
__device__ __forceinline__ void transpose_item(const float* W, int K, int Nsrc, int Ndst, bf16_t* WT, int mode, LAS float* scr, int item, int lane) {
    const int nblk = Ndst / 32, kb = item / nblk, nb = item % nblk, k0 = 64 * kb, n0 = 32 * nb;
    const int sc0 = colmap(n0, mode);
#pragma unroll 8
    for (int i = 0; i < 32; ++i) { const int kk = 2 * i + (lane >> 5); scr[kk * 33 + (lane & 31)] = (sc0 >= 0) ? W[(size_t)(k0 + kk) * Nsrc + sc0 + (lane & 31)] : 0.f; }
    LDS_WAIT(); asm volatile("" ::: "memory");
    const int c = lane & 7;
#pragma unroll
    for (int j = 0; j < 4; ++j) { const int n = (lane >> 3) + 8 * j; const LAS float* s = scr + (8 * c) * 33 + n;
        u32x4 o; o.x = pk2(s[0 * 33], s[1 * 33]); o.y = pk2(s[2 * 33], s[3 * 33]); o.z = pk2(s[4 * 33], s[5 * 33]); o.w = pk2(s[6 * 33], s[7 * 33]);
        *(u32x4*)(WT + (size_t)(n0 + n) * K + k0 + 8 * c) = o; }
    LDS_WAIT(); asm volatile("" ::: "memory");
}
__device__ __forceinline__ void ph_weights(const Args& a, LAS unsigned char* lds, int tid) {
    asm volatile("" : "+v"(tid));
    const int wave = tid >> 6, lane = tid & 63;
    LAS float* scr = (LAS float*)(lds + wave * 16384);
    const int gw = blockIdx.x * NWAVES + wave, NGW = gridDim.x * NWAVES;
    constexpr int I_IN = 16 * 64, I_O = 16 * 32, I_1 = 16 * 176, I_2 = 44 * 32, I_L = I_IN + I_O + I_1 + I_2;
    for (int it = gw; it < 2 * I_L; it += NGW) {
        const int l = it / I_L; int r = it % I_L;
        if (r < I_IN) { transpose_item(a.in[6] + (size_t)l * D * INC, D, INC, 2048, (bf16_t*)(a.ws + WS_WIN) + (size_t)l * 2048 * D, 1, scr, r, lane); continue; } r -= I_IN;
        if (r < I_O) { transpose_item(a.in[26] + (size_t)l * D * D, D, D, D, (bf16_t*)(a.ws + WS_WOUT) + (size_t)l * D * D, 0, scr, r, lane); continue; } r -= I_O;
        if (r < I_1) { transpose_item(a.in[31] + (size_t)l * D * 5632, D, 5632, 5632, (bf16_t*)(a.ws + WS_W1) + (size_t)l * 5632 * D, 2, scr, r, lane); continue; } r -= I_1;
        transpose_item(a.in[32] + (size_t)l * DFF * D, DFF, D, D, (bf16_t*)(a.ws + WS_W2) + (size_t)l * D * DFF, 0, scr, r, lane);
    }
}
__device__ __forceinline__ void ph_wf_init(const Args& a, int tid) {
    asm volatile("" : "+v"(tid));
    const size_t gtid = (size_t)blockIdx.x * NTHR + tid, gsz = (size_t)gridDim.x * NTHR;
    for (size_t idx = gtid; idx < (size_t)1 << 20; idx += gsz) {
        const int i = (int)idx, d = i & 63, dm = (i >> 6) & 1023, g = (i >> 16) & 3, s = (i >> 18) & 1, l = i >> 19;
        const float* wi = a.in[6] + ((size_t)l * D + dm) * INC + 1920 + g * 64;
        const float* wc = (const float*)(a.ws + WS_WCS) + (size_t)(((l * 4 + g) * 2 + s) * 64) * 64 + d;
        float acc = 0.f;
        for (int c = 0; c < 64; ++c) acc += wi[c] * wc[c * 64];
        ((bf16_t*)(a.ws + WS_WF))[((size_t)l * 512 + s * 256 + g * 64 + d) * 1024 + dm] = (bf16_t)f2bf(acc);
    }
    const float* MOD = (const float*)(a.ws + WS_MOD);
    for (size_t idx4 = gtid; idx4 < (size_t)MT * 256; idx4 += gsz) {
        const int r = (int)(idx4 >> 8), c = (int)(idx4 & 255) * 4;
        const int cond = row_cond(r);
        f32x4 v;
        if (r < MX) { v = *(const f32x4*)(a.in[0] + (size_t)r * D + c) + *(const f32x4*)((const float*)(a.ws + WS_POS) + (size_t)(r & 2047) * D + c); *(f32x4*)(a.out + (size_t)r * D + c) = v; }
        else { v = *(const f32x4*)(a.in[2] + (size_t)(r - MX) * D + c); *(f32x4*)((float*)(a.ws + WS_XSC) + (size_t)(r - MX) * D + c) = v; }
        const f32x4 sh = *(const f32x4*)(modp(MOD, 0, cond, 0) + c), sc = *(const f32x4*)(modp(MOD, 0, cond, 1) + c);
        const f32x4 h = v * (sc + 1.0f) + sh;
        u32x2 w; w.x = pk2(h[0], h[1]); w.y = pk2(h[2], h[3]);
        *(u32x2*)((bf16_t*)(a.ws + WS_A) + (size_t)r * D + c) = w;
    }
}
__device__ __forceinline__ void ph_pool(const Args& a, LAS unsigned char* lds, int tid, int l, int rows) {
    asm volatile("" : "+v"(tid));
    const int half = tid >> 8, ch = tid & 255, g = ch >> 6;
    LAS float* sd = (LAS float*)lds + half * 256;
    const float* pw = a.in[18] + (size_t)(l * 4 + g) * 4096 + (ch & 63);
    const float psc = a.in[19][l * GW + ch];
    for (int it = blockIdx.x; it < rows / 2; it += gridDim.x) {
        const int row = 2 * it + half;
        const int t = row < MX ? (row & 2047) : ((row - MX) & 255), Ls = row < MX ? SEQ : CTXL;
        const bf16_t* Z = (const bf16_t*)(a.ws + WS_Z) + (size_t)row * ZW + ZC_POOL + ch;
        const int w = 2 << g;
        int lo = t - w / 2; if (lo < 0) lo = 0;
        int hi = t + w - w / 2; if (hi > Ls) hi = Ls;
        float s = 0.f;
        for (int i = lo; i < hi; ++i) s += bf2f(Z[(ptrdiff_t)(i - t) * ZW]);
        sd[ch] = s / (float)(hi - lo) - bf2f(Z[0]);
        __syncthreads();
        float acc = 0.f;
        for (int c = 0; c < 64; ++c) acc += sd[g * 64 + c] * pw[c * 64];
        ((bf16_t*)(a.ws + WS_CAT))[(size_t)row * D + 256 + ch] = (bf16_t)f2bf(acc * psc);
        __syncthreads();
    }
}
__device__ __forceinline__ void ph_gmlp(const Args& a, LAS unsigned char* lds, int tid, int l, int rows) {
    asm volatile("" : "+v"(tid));
    const int half = tid >> 8, t2 = tid & 255, p = t2 >> 1, hf = t2 & 1;
    LAS float* vln = (LAS float*)lds + half * (128 * 65);
    const int ntask = rows / 128 * 4;
    for (int it = blockIdx.x; it < ntask / 2; it += gridDim.x) {
        const int task = 2 * it + half, chunk = task >> 2, g = task & 3;
        const int rowb = chunk * 128;
        const bf16_t* Z = (const bf16_t*)(a.ws + WS_Z) + (size_t)(rowb + p) * ZW;
        float v[32]; float s = 0.f;
#pragma unroll
        for (int c = 0; c < 32; ++c) { v[c] = bf2f(Z[ZC_GV + g * 64 + hf * 32 + c]); s += v[c]; }
        s += __shfl_xor(s, 1);
        const float mu = s * (1.f / 64.f); float q = 0.f;
#pragma unroll
        for (int c = 0; c < 32; ++c) { v[c] -= mu; q += v[c] * v[c]; }
        q += __shfl_xor(q, 1);
        const float rstd = rsqrtf(q * (1.f / 64.f) + LN_EPS);
#pragma unroll
        for (int c = 0; c < 32; ++c) { const int cc = g * 64 + hf * 32 + c; vln[p * 65 + hf * 32 + c] = v[c] * rstd * a.in[20][l * GW + cc] + a.in[21][l * GW + cc]; }
        __syncthreads();
        const float* ws = a.in[22] + ((size_t)(l * 4 + g) * 128 + p) * 128;
        float acc[32];
#pragma unroll
        for (int c = 0; c < 32; ++c) acc[c] = 0.f;
        for (int qq = 0; qq < 128; ++qq) { const float wv = ws[qq];
#pragma unroll
            for (int c = 0; c < 32; ++c) acc[c] += wv * vln[qq * 65 + hf * 32 + c]; }
        const float bs = a.in[23][(l * 4 + g) * 128 + p];
        bf16_t* o = (bf16_t*)(a.ws + WS_CAT) + (size_t)(rowb + p) * D + 512 + g * 64 + hf * 32;
#pragma unroll
        for (int c = 0; c < 32; ++c) o[c] = (bf16_t)f2bf(bf2f(Z[ZC_GU + g * 64 + hf * 32 + c]) * (acc[c] + bs));
        __syncthreads();
    }
}
__device__ __forceinline__ void ph_readout(const Args& a, LAS unsigned char* lds, int tid, int l, int rows) {
    asm volatile("" : "+v"(tid));
    const int half = tid >> 8, ch = tid & 255, h = ch >> 6;
    LAS float* sg = (LAS float*)lds + half * 128;
    const float* conv = a.in[7] + (size_t)l * 3 * 768 + 512 + ch;
    const float c0 = conv[0], c1 = conv[768], c2 = conv[1536];
    const float gng = a.in[16][l * GW + ch], gnb = a.in[17][l * GW + ch];
    const float* g2 = a.in[12] + (size_t)l * 128 * GW + ch;
    for (int it = blockIdx.x; it < rows / 2; it += gridDim.x) {
        const int row = 2 * it + half;
        const int t = row < MX ? (row & 2047) : ((row - MX) & 255), Ls = row < MX ? SEQ : CTXL;
        const bf16_t* Z = (const bf16_t*)(a.ws + WS_Z) + (size_t)row * ZW;
        const bf16_t* Yf = (const bf16_t*)(a.ws + WS_Y) + (size_t)row * GW;
        const bf16_t* Yb = Yf + (size_t)MT * GW;
        const float* BS = (const float*)(a.ws + WS_BS) + (size_t)row * 8;
        if (ch < 128) sg[ch] = bf2f(Z[ZC_DG + ch]);
        __syncthreads();
        const float y = bf2f(Yf[ch]) + bf2f(Yb[ch]);
        const float mu = wave_sum(y) * (1.f / 64.f);
        const float dv = y - mu;
        const float var = wave_sum(dv * dv) * (1.f / 64.f);
        float v = c1 * bf2f(Z[ZC_V + ch]);
        if (t > 0) v += c0 * bf2f(Z[ZC_V + ch - ZW]);
        if (t < Ls - 1) v += c2 * bf2f(Z[ZC_V + ch + ZW]);
        float gate = 0.f;
        for (int j = 0; j < 128; ++j) gate += sg[j] * g2[j * GW];
        const float o = (dv * rsqrtf(var + GN_EPS) * gng + gnb + (BS[h * 2] + BS[h * 2 + 1]) * v) * gate;
        ((bf16_t*)(a.ws + WS_CAT))[(size_t)row * D + ch] = (bf16_t)f2bf(o);
        __syncthreads();
    }
}
__device__ __forceinline__ void ph_scan_naive(const Args& a, LAS unsigned char* lds, int tid, int l) {
    asm volatile("" : "+v"(tid));
    if (tid >= 64) return;
    LAS float* sv = (LAS float*)lds;
    const int lane = tid;
    for (int bid = blockIdx.x; bid < 128; bid += gridDim.x) {
        const int d = bid & 1, h = (bid >> 1) & 3, b = bid >> 3;
        const int ch = h * 64 + lane;
        const bf16_t* Z = (const bf16_t*)(a.ws + WS_Z);
        bf16_t* Y = (bf16_t*)(a.ws + WS_Y) + (size_t)d * MT * GW;
        float* BS = (float*)(a.ws + WS_BS);
        const float* conv = a.in[7] + (size_t)l * 3 * 768;
        float cw[3][3];
#pragma unroll
        for (int q = 0; q < 3; ++q)
#pragma unroll
            for (int tp = 0; tp < 3; ++tp) cw[q][tp] = conv[tp * 768 + q * 256 + ch];
        const float w0 = a.in[8][(l * 2 + d) * GW + ch], a0 = a.in[10][(l * 2 + d) * GW + ch];
        const float* w2 = a.in[9] + (size_t)(l * 2 + d) * 64 * GW + ch;
        const float* a2 = a.in[11] + (size_t)(l * 2 + d) * 64 * GW + ch;
        const float kkw = a.in[13][l * GW + ch], kaw = a.in[14][l * GW + ch], rkw = a.in[15][l * GW + ch];
        float S[64];
#pragma unroll
        for (int k = 0; k < 64; ++k) S[k] = 0.f;
        for (int seg = 0; seg < 2; ++seg) {
            const int Ls = seg == 0 ? CTXL : SEQ;
            const int base = seg == 0 ? MX + b * CTXL : b * SEQ;
            for (int s = 0; s < Ls; ++s) {
                const int t = d ? (Ls - 1 - s) : s;
                const size_t row = (size_t)(base + t);
                const bf16_t* zr = Z + row * ZW;
                float rkv[3];
#pragma unroll
                for (int q = 0; q < 3; ++q) {
                    const int col = q * 256 + ch;
                    float x = cw[q][1] * bf2f(zr[col]);
                    if (t > 0) x += cw[q][0] * bf2f(zr[col - ZW]);
                    if (t < Ls - 1) x += cw[q][2] * bf2f(zr[col + ZW]);
                    rkv[q] = x;
                }
                const float r = rkv[0], k = rkv[1], v = rkv[2];
                const float kkr = k * kkw;
                const float nrm = sqrtf(wave_sum(kkr * kkr));
                const float kk = kkr / fmaxf(nrm, 1e-12f);
                float lw = w0, av = a0;
                for (int j = 0; j < 64; ++j) { lw += bf2f(zr[ZC_DW + d * 64 + j]) * w2[j * GW]; av += bf2f(zr[ZC_DA + d * 64 + j]) * a2[j * GW]; }
                const float nx = -lw;
                const float sp = fmaxf(nx, 0.f) + log1pf(expf(-fabsf(nx)));
                const float logw = -sp - 0.5f;
                const float w = expf(-expf(logw));
                const float aa = 1.f / (1.f + expf(-av));
                const float kd = k * (1.f + (aa - 1.f) * kaw);
                const float bsum = wave_sum(r * kd * rkw);
                if (lane == 0) BS[row * 8 + h * 2 + d] = bsum;
                LDS_WAIT(); asm volatile("" ::: "memory");
                sv[lane] = w; sv[64 + lane] = kk; sv[128 + lane] = kk * aa; sv[192 + lane] = kd; sv[256 + lane] = r;
                LDS_WAIT(); asm volatile("" ::: "memory");
                float skk = 0.f;
#pragma unroll
                for (int q = 0; q < 64; ++q) skk -= S[q] * sv[64 + q];
                float y = 0.f;
#pragma unroll
                for (int q = 0; q < 64; ++q) { S[q] = S[q] * sv[q] + skk * sv[128 + q] + v * sv[192 + q]; y += S[q] * sv[256 + q]; }
                Y[row * GW + ch] = (bf16_t)f2bf(y);
            }
        }
    }
}
__device__ __forceinline__ void ph_ln(const Args& a, int tid, const float* lg, const float* lb, int lA, int whichsh, int nrows) {
    asm volatile("" : "+v"(tid));
    const int wave = tid >> 6, lane = tid & 63;
    const float* MOD = (const float*)(a.ws + WS_MOD);
    for (int row = blockIdx.x * NWAVES + wave; row < nrows; row += gridDim.x * NWAVES) {
        float* xp = (row < MX) ? a.out + (size_t)row * D : (float*)(a.ws + WS_XSC) + (size_t)(row - MX) * D;
        f32x4 v[4]; float s = 0.f;
#pragma unroll
        for (int j = 0; j < 4; ++j) { v[j] = *(const f32x4*)(xp + j * 256 + lane * 4); s += (v[j][0] + v[j][1]) + (v[j][2] + v[j][3]); }
        const float mu = wave_sum(s) * (1.f / D); float q = 0.f;
#pragma unroll
        for (int j = 0; j < 4; ++j) { v[j] = v[j] - mu; q += (v[j][0] * v[j][0] + v[j][1] * v[j][1]) + (v[j][2] * v[j][2] + v[j][3] * v[j][3]); }
        const float rstd = rsqrtf(wave_sum(q) * (1.f / D) + LN_EPS);
        const int cond = row_cond(row);
#pragma unroll
        for (int j = 0; j < 4; ++j) {
            const int c = j * 256 + lane * 4;
            const f32x4 o = v[j] * rstd * *(const f32x4*)(lg + c) + *(const f32x4*)(lb + c);
            *(f32x4*)(xp + c) = o;
            if (lA >= 0) {
                const f32x4 sh = *(const f32x4*)(modp(MOD, lA, cond, whichsh) + c), sc = *(const f32x4*)(modp(MOD, lA, cond, whichsh + 1) + c);
                const f32x4 hh = o * (sc + 1.0f) + sh;
                u32x2 w; w.x = pk2(hh[0], hh[1]); w.y = pk2(hh[2], hh[3]);
                *(u32x2*)((bf16_t*)(a.ws + WS_A) + (size_t)row * D + c) = w;
            }
        }
    }
}

__global__ void __launch_bounds__(NTHR, 2) mk_fwd(Args a) {
    extern __shared__ __attribute__((aligned(16))) unsigned char lds_raw[];
    LAS unsigned char* lds = (LAS unsigned char*)lds_raw;
    volatile LAS unsigned* MISC = (volatile LAS unsigned*)(lds + MISC_OFF);
    int tid = threadIdx.x;
    const int G = gridDim.x, bx = blockIdx.x;
    for (int u = tid; u < (LDS_BYTES - LDSCTL_OFF) / 4; u += NTHR) ((LAS unsigned*)(lds + LDSCTL_OFF))[u] = 0u;
    __syncthreads();
    gu32* ctl = (gu32*)(a.ws + WS_CTL);
    XcdBarrier bar = xcd_barrier_post((unsigned*)(ctl + CW_BAR) + a.li * XCD_BAR_WORDS, MISC + 8);
    const int lo = a.ph_lo, hi = a.ph_hi;
#define IN(k) (lo <= (k) && (k) < hi)
#define SEAM(k) do { if (IN(k) && IN((k) + 1)) xcd_barrier(bar); } while (0)
    unsigned char* ws = a.ws;
    bf16_t* A = (bf16_t*)(ws + WS_A); bf16_t* Z = (bf16_t*)(ws + WS_Z); bf16_t* Cat = (bf16_t*)(ws + WS_CAT); bf16_t* H = (bf16_t*)(ws + WS_H);
    bf16_t* ZTX = (bf16_t*)(ws + WS_ZTX); bf16_t* ZTC = (bf16_t*)(ws + WS_ZTC);
    const float* MOD = (const float*)(ws + WS_MOD);

    if (IN(0)) { ph_mod(a, lds, tid); __syncthreads(); ph_tables(a, tid); ph_weights(a, lds, tid); }
    SEAM(0);
    if (IN(1)) { ph_wf_init(a, tid); }
    SEAM(1);
    for (int l = 0; l < 2; ++l) {
        const int pb = 2 + 8 * l;
        const bool last = (l == 1);
        const int rows = last ? MX : MT;
        const bf16_t* WinT = (const bf16_t*)(ws + WS_WIN) + (size_t)l * 2048 * 1024;
        const bf16_t* WfT = (const bf16_t*)(ws + WS_WF) + (size_t)l * 512 * 1024;
        const bf16_t* WoT = (const bf16_t*)(ws + WS_WOUT) + (size_t)l * D * D;
        const bf16_t* W1T = (const bf16_t*)(ws + WS_W1) + (size_t)l * 5632 * 1024;
        const bf16_t* W2T = (const bf16_t*)(ws + WS_W2) + (size_t)l * D * DFF;
        if (IN(pb + 0)) {
            { pg8::Gemm g{A, WinT, MT, ZW, D}; pg8::Order2 S{MX / 256, 8, MC / 256, last ? 5 : 8, G, bx}; pg8::EpiZ E{Z};
              pg8::gemm_phase<pg8::EpiZ, pg8::Order2, true, true>(lds, g, S, E); }
            { pg8::Gemm g{WfT, A, 512, rows, D}; pg8::Order2 S{2, rows / 256, 0, 0, G, bx}; pg8::EpiZT E{ZTX, ZTC};
              pg8::gemm_phase<pg8::EpiZT, pg8::Order2, true, true>(lds, g, S, E); }
        }
        SEAM(pb + 0);
        if (IN(pb + 1)) { ph_pool(a, lds, tid, l, rows); ph_gmlp(a, lds, tid, l, rows); ph_scan_naive(a, lds, tid, l); }
        SEAM(pb + 1);
        if (IN(pb + 2)) {
            ph_readout(a, lds, tid, l, rows);
            __syncthreads();
            for (int j = 0; j < (last ? 1 : 2); ++j) {
                pg8::Gemm g{j == 0 ? (const bf16_t*)(ws + WS_DFTX) : (const bf16_t*)(ws + WS_DFTC), j == 0 ? ZTX : ZTC, j == 0 ? SEQ : CTXL, 4096, j == 0 ? 4096 : 512};
                pg8::Order2 S{j == 0 ? 8 : 1, 16, 0, 0, G, bx}; pg8::EpiFourier E{Cat, a.in[25] + l * GW, j == 0 ? 0 : MX, j == 0 ? SEQ : CTXL};
                pg8::gemm_phase<pg8::EpiFourier, pg8::Order2, true, true>(lds, g, S, E);
            }
        }
        SEAM(pb + 2);
        if (IN(pb + 3)) { pg8::Gemm g{Cat, WoT, rows, D, D}; pg8::Order2 S{rows / 256, 4, 0, 0, G, bx}; pg8::EpiRes E{a.out, (float*)(ws + WS_XSC), MOD + (size_t)(l * 17) * 6144 + 2 * 1024};
            pg8::gemm_phase<pg8::EpiRes, pg8::Order2, true, true>(lds, g, S, E); }
        SEAM(pb + 3);
        if (IN(pb + 4)) ph_ln(a, tid, a.in[27] + l * D, a.in[28] + l * D, l, 3, rows);
        SEAM(pb + 4);
        if (IN(pb + 5)) { pg8::Gemm g{A, W1T, rows, 5632, D}; pg8::Order2 S{rows / 256, 22, 0, 0, G, bx}; pg8::EpiSwiglu E{H};
            pg8::gemm_phase<pg8::EpiSwiglu, pg8::Order2, true, true>(lds, g, S, E); }
        SEAM(pb + 5);
        if (IN(pb + 6)) { pg8::Gemm g{H, W2T, rows, D, DFF}; pg8::Order2 S{rows / 256, 4, 0, 0, G, bx}; pg8::EpiRes E{a.out, (float*)(ws + WS_XSC), MOD + (size_t)(l * 17) * 6144 + 5 * 1024};
            pg8::gemm_phase<pg8::EpiRes, pg8::Order2, true, true>(lds, g, S, E); }
        SEAM(pb + 6);
        if (IN(pb + 7)) ph_ln(a, tid, a.in[29] + l * D, a.in[30] + l * D, last ? -1 : l + 1, 0, rows);
        if (!last) SEAM(pb + 7);
    }
#undef IN
#undef SEAM
}

#ifndef MK_CUTS
#define MK_CUTS {0, NPHASE}
#endif
extern "C" void kernel_launch(void* const* d_in, const int* in_sizes, int n_in, void* d_out, int out_size, void* d_ws, size_t ws_size, hipStream_t stream) {
    static int grid = 0;
    if (grid == 0) {
        if (n_in != 33 || ws_size < WS_END) { fprintf(stderr, "kernel_launch: unexpected n_in %d / ws_size %zu\n", n_in, ws_size); grid = -1; return; }
        int dev = 0, cus = 0, per_cu = 0;
        if (hipGetDevice(&dev) != hipSuccess || hipDeviceGetAttribute(&cus, hipDeviceAttributeMultiprocessorCount, dev) != hipSuccess) { grid = -1; return; }
        if (hipFuncSetAttribute((const void*)mk_fwd, hipFuncAttributeMaxDynamicSharedMemorySize, LDS_BYTES) != hipSuccess) { fprintf(stderr, "kernel_launch: hipFuncSetAttribute failed\n"); grid = -1; return; }
        if (hipOccupancyMaxActiveBlocksPerMultiprocessor(&per_cu, (const void*)mk_fwd, NTHR, LDS_BYTES) != hipSuccess || per_cu < 1) { fprintf(stderr, "kernel_launch: occupancy query says %d blocks per CU\n", per_cu); per_cu = 1; }
        (void)hipGetLastError();
        grid = cus;
    }
    if (grid < 0) return;
    (void)hipMemsetAsync((char*)d_ws + WS_CTL, 0, CTL_ZERO_BYTES, stream);
    Args a{};
    for (int i = 0; i < 33; ++i) a.in[i] = (const float*)d_in[i];
    a.out = (float*)d_out; a.ws = (unsigned char*)d_ws;
    const int cuts[] = MK_CUTS; const int ncut = (int)(sizeof(cuts) / sizeof(int)) - 1;
    for (int li = 0; li < ncut; ++li) {
        a.ph_lo = cuts[li]; a.ph_hi = cuts[li + 1]; a.li = li;
        hipLaunchKernelGGL(mk_fwd, dim3(grid), dim3(NTHR), LDS_BYTES, stream, a);
    }
}
```

```cpp
#include <hip/hip_runtime.h>
#include <cstdint>
#include <cstdio>

constexpr int D = 1024, NB = 16, SEQ = 2048, CTXL = 256;
constexpr int MX = NB * SEQ;
constexpr int MC = NB * CTXL;
constexpr int MT = MX + MC;
constexpr int GW = 256;
constexpr int INC = 2176;
constexpr int ZW = 2048;
constexpr int DFF = 2816;
constexpr float ALPHA = 1.4142135623730951f;
constexpr float LN_EPS = 1e-5f, GN_EPS = 64e-5f;
constexpr int ZC_R = 0, ZC_K = 256, ZC_V = 512, ZC_DW = 768, ZC_DA = 896, ZC_DG = 1024, ZC_POOL = 1280, ZC_GU = 1536, ZC_GV = 1792;

constexpr size_t MiB = 1u << 20;
constexpr size_t WS_CTL = 0, CTL_ZERO_BYTES = 256 * 1024;
constexpr size_t WS_MOD = 1 * MiB;
constexpr size_t WS_WCS = 2 * MiB;
constexpr size_t WS_LT = 3 * MiB;
constexpr size_t WS_POS = 10 * MiB;
constexpr size_t WS_WIN = 18 * MiB;
constexpr size_t WS_WF = 26 * MiB;
constexpr size_t WS_WOUT = 28 * MiB;
constexpr size_t WS_W1 = 32 * MiB;
constexpr size_t WS_W2 = 54 * MiB;
constexpr size_t WS_DFTX = 65 * MiB;
constexpr size_t WS_DFTC = 81 * MiB;
constexpr size_t WS_XSC = 82 * MiB;
constexpr size_t WS_A = 98 * MiB;
constexpr size_t WS_Z = 170 * MiB;
constexpr size_t WS_CAT = 314 * MiB;
constexpr size_t WS_H = 170 * MiB;
constexpr size_t WS_ZTX = 386 * MiB;
constexpr size_t WS_ZTC = 418 * MiB;
constexpr size_t WS_Y = 422 * MiB;
constexpr size_t WS_BS = 458 * MiB;
constexpr size_t WS_END = 460 * MiB;
constexpr int CW_BAR = 4096;

#define GAS __attribute__((address_space(1)))
#define LAS __attribute__((address_space(3)))
typedef GAS unsigned gu32;
#define RLX_AGENT __ATOMIC_RELAXED, __HIP_MEMORY_SCOPE_AGENT
#define LDS_WAIT() asm volatile("s_waitcnt lgkmcnt(0)" ::: "memory")
#define VM_WAIT() asm volatile("s_waitcnt vmcnt(0)" ::: "memory")

__device__ __forceinline__ unsigned f2bf(float f) { unsigned u = __builtin_bit_cast(unsigned, f); return (u + 0x7fffu + ((u >> 16) & 1u)) >> 16; }
__device__ __forceinline__ unsigned pk2(float lo, float hi) { return f2bf(lo) | (f2bf(hi) << 16); }

namespace pg8 {
#define PG8_LAS __attribute__((address_space(3)))
typedef unsigned short bf16_t;
typedef short bf16x8 __attribute__((ext_vector_type(8)));
typedef float f32x4 __attribute__((ext_vector_type(4)));
typedef unsigned u32x4 __attribute__((ext_vector_type(4)));
constexpr int BM = 256, BK = 64, HALF = 128, HTB = HALF * BK * 2  , STAGE_BYTES = 8 * HTB, NXCD = 8, WGM = 8;

__host__ __device__ __forceinline__ int lds_byte(int r, int c) { const int st = (r >> 4) * 2 + (c >> 5), rr = r & 15, cc = c & 31, ob = rr * 64 + cc * 2; return st * 1024 + (ob ^ (((ob >> 9) & 1) << 5)); }
__host__ __device__ __forceinline__ void stage_rc(int b, int& R, int& C) { const int st = b / 1024, sb = b % 1024, swz = sb ^ (((sb >> 9) & 1) << 5); R = (st >> 1) * 16 + swz / 64; C = (st & 1) * 32 + (swz % 64) / 2; }
__host__ __device__ __forceinline__ int perm32(int rho) { const int n = rho >> 4, i = rho & 15; return 8 * (i >> 2) + 4 * n + (i & 3); }

struct Unit { int pm, pn; };
struct Gemm { const bf16_t* A; const bf16_t* Bt; int M, N, K; };

struct StaticOrder {
    int nM, nN, nwg, G, c;
    __host__ __device__ void init(int M, int N, int G_, int c_) { nM = M / BM; nN = N / BM; nwg = nM * nN; G = G_; c = c_; }
    __host__ __device__ bool next(int i, Unit& u) const {
        const long L = (long)i * G + c; if (L >= nwg) return false;
        int wgid = (int)L; { const int q = nwg / NXCD, r = nwg % NXCD, xcd = wgid % NXCD, off = wgid / NXCD; wgid = (xcd < r ? xcd * (q + 1) : r * (q + 1) + (xcd - r) * q) + off; }
        const int nig = WGM * nN, gid = wgid / nig, fm = gid * WGM, gsz = (nM - fm) < WGM ? (nM - fm) : WGM;
        u.pm = fm + ((wgid % nig) % gsz); u.pn = (wgid % nig) / gsz; return true;
    }
    __device__ __forceinline__ void a_ready(const Unit&) const {}
    __device__ __forceinline__ void done(const Unit&) const {}
};


__device__ __forceinline__ void tile_map(int wgid, int nM, int nN, int& pm, int& pn) {
    const int nwg = nM * nN;
    { const int q = nwg / NXCD, r = nwg % NXCD, xcd = wgid % NXCD, off = wgid / NXCD; wgid = (xcd < r ? xcd * (q + 1) : r * (q + 1) + (xcd - r) * q) + off; }
    const int nig = WGM * nN, gid = wgid / nig, fm = gid * WGM, gsz = (nM - fm) < WGM ? (nM - fm) : WGM;
    pm = fm + ((wgid % nig) % gsz); pn = (wgid % nig) / gsz;
}
struct Order2 {
    int nM0, nN0, nM1, nN1, G, c;
    __device__ __forceinline__ bool next(int i, Unit& u) const {
        const int n0 = nM0 * nN0, n1 = nM1 * nN1; const long L = (long)i * G + c; if (L >= n0 + n1) return false;
        if (L < n0) tile_map((int)L, nM0, nN0, u.pm, u.pn); else { tile_map((int)L - n0, nM1, nN1, u.pm, u.pn); u.pm += nM0; }
        return true;
    }
    __device__ __forceinline__ void a_ready(const Unit&) const {}
    __device__ __forceinline__ void done(const Unit&) const {}
};

__device__ __forceinline__ unsigned cvt_pk_bf16(float lo, float hi) { unsigned r; asm volatile("v_cvt_pk_bf16_f32 %0, %1, %2" : "=v"(r) : "v"(lo), "v"(hi)); return r; }
__device__ __forceinline__ float fsig(float y) { return __builtin_amdgcn_rcpf(1.0f + __builtin_amdgcn_exp2f(-1.4426950408889634f * y)); }
__device__ __forceinline__ float fact(float x, int kind) {
    if (kind == 1) return 2.0f * fsig(2.0f * x) - 1.0f;
    if (kind == 2) return fsig(x);
    if (kind == 3) return x * fsig(1.5957691216057308f * (x + 0.044715f * x * x * x));
    return x;
}
struct EpiZ {
    static constexpr bool PERM = true, AFTER_DRAIN = false;
    bf16_t* Z;
    __device__ __forceinline__ void operator()(const f32x4 (&acc)[2][2][4][2], const Unit& u, int wr, int wc, int fr, int fq) const {
        const int row0 = u.pm * BM + wr * 64 + fr, col0 = u.pn * BM + wc * 32 + 8 * fq;
        int kind[2] = {0, 0};
        if (u.pn == 3) kind[0] = 1; else if (u.pn == 4) kind[0] = 2; else if (u.pn >= 6) { kind[0] = 3; kind[1] = 3; }
#pragma unroll
        for (int ai = 0; ai < 2; ++ai)
#pragma unroll
            for (int m = 0; m < 4; ++m) { bf16_t* rowp = Z + (size_t)(row0 + ai * HALF + m * 16) * ZW + col0;
#pragma unroll
                for (int bj = 0; bj < 2; ++bj) { f32x4 v0 = acc[ai][bj][m][0], v1 = acc[ai][bj][m][1]; const int kd = kind[bj];
                    if (kd) {
#pragma unroll
                        for (int e = 0; e < 4; ++e) { v0[e] = fact(v0[e], kd); v1[e] = fact(v1[e], kd); } }
                    u32x4 w; w.x = cvt_pk_bf16(v0[0], v0[1]); w.y = cvt_pk_bf16(v0[2], v0[3]); w.z = cvt_pk_bf16(v1[0], v1[1]); w.w = cvt_pk_bf16(v1[2], v1[3]);
                    *(u32x4*)(rowp + bj * HALF) = w; } }
    }
};
struct EpiZT {
    static constexpr bool PERM = true, AFTER_DRAIN = false;
    bf16_t* ZTX; bf16_t* ZTC;
    __device__ __forceinline__ void operator()(const f32x4 (&acc)[2][2][4][2], const Unit& u, int wr, int wc, int fr, int fq) const {
        const int tok0 = u.pn * BM, s = u.pm; bf16_t* base; int ld;
        if (tok0 < MX) { const int b = tok0 >> 11, t0 = tok0 & 2047; base = ZTX + (size_t)(b * 256) * 4096 + s * 2048 + t0; ld = 4096; }
        else { const int b = (tok0 - MX) >> 8; base = ZTC + (size_t)(b * 256) * 512 + s * 256; ld = 512; }
        const int n0 = wr * 64 + fr, c0 = wc * 32 + 8 * fq;
#pragma unroll
        for (int ai = 0; ai < 2; ++ai)
#pragma unroll
            for (int m = 0; m < 4; ++m) { bf16_t* rowp = base + (size_t)(n0 + ai * HALF + m * 16) * ld + c0;
#pragma unroll
                for (int bj = 0; bj < 2; ++bj) { const f32x4 v0 = acc[ai][bj][m][0], v1 = acc[ai][bj][m][1];
                    u32x4 w; w.x = cvt_pk_bf16(v0[0], v0[1]); w.y = cvt_pk_bf16(v0[2], v0[3]); w.z = cvt_pk_bf16(v1[0], v1[1]); w.w = cvt_pk_bf16(v1[2], v1[3]);
                    *(u32x4*)(rowp + bj * HALF) = w; } }
    }
};
struct EpiFourier {
    static constexpr bool PERM = true, AFTER_DRAIN = false;
    bf16_t* Cat; const float* fb; int rowbase, Ls;
    __device__ __forceinline__ void operator()(const f32x4 (&acc)[2][2][4][2], const Unit& u, int wr, int wc, int fr, int fq) const {
        const int row0 = rowbase + u.pn * Ls + u.pm * BM + wr * 64 + fr, c0 = wc * 32 + 8 * fq;
        f32x4 bv[2][2];
#pragma unroll
        for (int bj = 0; bj < 2; ++bj)
#pragma unroll
            for (int n = 0; n < 2; ++n) bv[bj][n] = *(const f32x4*)(fb + c0 + bj * HALF + 4 * n);
#pragma unroll
        for (int ai = 0; ai < 2; ++ai)
#pragma unroll
            for (int m = 0; m < 4; ++m) { bf16_t* rowp = Cat + (size_t)(row0 + ai * HALF + m * 16) * D + 768 + c0;
#pragma unroll
                for (int bj = 0; bj < 2; ++bj) { const f32x4 v0 = acc[ai][bj][m][0] + bv[bj][0], v1 = acc[ai][bj][m][1] + bv[bj][1];
                    u32x4 w; w.x = cvt_pk_bf16(v0[0], v0[1]); w.y = cvt_pk_bf16(v0[2], v0[3]); w.z = cvt_pk_bf16(v1[0], v1[1]); w.w = cvt_pk_bf16(v1[2], v1[3]);
                    *(u32x4*)(rowp + bj * HALF) = w; } }
    }
};
struct EpiRes {
    static constexpr bool PERM = false, AFTER_DRAIN = false;
    float* out; float* xsc; const float* gmod;
    __device__ __forceinline__ void operator()(const f32x4 (&acc)[2][2][4][2], const Unit& u, int wr, int wc, int fr, int fq) const {
        const int prow = u.pm * BM; const bool isx = prow < MX;
        float* base = isx ? out + (size_t)prow * D : xsc + (size_t)(prow - MX) * D;
        const float* g = gmod + (size_t)(isx ? (prow >> 11) : 16) * 6144;
        const int col0 = u.pn * BM + wc * 32 + 4 * fq;
        f32x4 gv[2][2];
#pragma unroll
        for (int bj = 0; bj < 2; ++bj)
#pragma unroll
            for (int n = 0; n < 2; ++n) gv[bj][n] = *(const f32x4*)(g + col0 + bj * HALF + n * 16);
#pragma unroll
        for (int ai = 0; ai < 2; ++ai)
#pragma unroll
            for (int m = 0; m < 4; ++m) { float* rowp = base + (size_t)(ai * HALF + wr * 64 + m * 16 + fr) * D + col0;
#pragma unroll
                for (int bj = 0; bj < 2; ++bj)
#pragma unroll
                    for (int n = 0; n < 2; ++n) { float* p = rowp + bj * HALF + n * 16; const f32x4 x = *(const f32x4*)p; *(f32x4*)p = x * ALPHA + gv[bj][n] * acc[ai][bj][m][n]; } }
    }
};
struct EpiSwiglu {
    static constexpr bool PERM = true, AFTER_DRAIN = false;
    bf16_t* H;
    __device__ __forceinline__ void operator()(const f32x4 (&acc)[2][2][4][2], const Unit& u, int wr, int wc, int fr, int fq) const {
        const int row0 = u.pm * BM + wr * 64 + fr, col0 = u.pn * HALF + wc * 32 + 8 * fq;
#pragma unroll
        for (int ai = 0; ai < 2; ++ai)
#pragma unroll
            for (int m = 0; m < 4; ++m) { f32x4 h0, h1; const f32x4 g0 = acc[ai][0][m][0], g1 = acc[ai][0][m][1], u0 = acc[ai][1][m][0], u1 = acc[ai][1][m][1];
#pragma unroll
                for (int e = 0; e < 4; ++e) { h0[e] = g0[e] * fsig(g0[e]) * u0[e]; h1[e] = g1[e] * fsig(g1[e]) * u1[e]; }
                u32x4 w; w.x = cvt_pk_bf16(h0[0], h0[1]); w.y = cvt_pk_bf16(h0[2], h0[3]); w.z = cvt_pk_bf16(h1[0], h1[1]); w.w = cvt_pk_bf16(h1[2], h1[3]);
                *(u32x4*)(H + (size_t)(row0 + ai * HALF + m * 16) * DFF + col0) = w; }
    }
};

template <class Epi, class Sched, bool ALIGN_EPI = false, bool SP2 = false>
__device__ __forceinline__ void gemm_phase(PG8_LAS unsigned char* lds, const Gemm g, const Sched& S, const Epi& E) {
    int tid_ = threadIdx.x; asm volatile("" : "+v"(tid_));
    const int tid = tid_, wid = __builtin_amdgcn_readfirstlane(tid >> 6), lane = tid & 63, wr = wid >> 2, wc = wid & 3, fr = lane & 15, fq = lane >> 4;
    const int K = g.K, nt = K / BK;
    unsigned voffA[2], voffB[2];
#pragma unroll
    for (int i = 0; i < 2; ++i) { int R, C; stage_rc(tid * 16 + i * 8192, R, C); const int Rb = Epi::PERM ? ((R & ~31) + perm32(R & 31)) : R;
        voffA[i] = (unsigned)(R * K + C) * 2u; voffB[i] = (unsigned)(Rb * K + C) * 2u; }
    const size_t kstep = (size_t)(BK * 2);
    const size_t hstep = (size_t)HALF * K * 2;
    const size_t tstep = 2 * hstep;
    const unsigned ldsw = (unsigned)wid * 1024u;
    const int aoff = lds_byte(wr * 64 + fr, fq * 8), boff = lds_byte(wc * 32 + fr, fq * 8);
#define PG8_SA(b, h) (((b) * 2 + (h)) * HTB)
#define PG8_SB(b, h) ((4 + (b) * 2 + (h)) * HTB)
#define PG8_STAGE(bufoff, gbase, voff) do { _Pragma("unroll") for (int _i = 0; _i < 2; ++_i) \
        __builtin_amdgcn_global_load_lds((const unsigned*)((const char*)(gbase) + (voff)[_i]), (PG8_LAS unsigned*)(lds + (bufoff) + ldsw + _i * 8192), 16, 0, 0); } while (0)
#define PG8_LDA(dst, b, h) do { _Pragma("unroll") for (int m = 0; m < 4; ++m) _Pragma("unroll") for (int k = 0; k < 2; ++k) dst[m][k] = *(const PG8_LAS bf16x8*)(lds + PG8_SA(b, h) + aoff + m * 2048 + k * 1024); } while (0)
#define PG8_LDB(dst, b, h) do { _Pragma("unroll") for (int n = 0; n < 2; ++n) _Pragma("unroll") for (int k = 0; k < 2; ++k) dst[n][k] = *(const PG8_LAS bf16x8*)(lds + PG8_SB(b, h) + boff + n * 2048 + k * 1024); } while (0)
#define PG8_MMA(ai, bj, At, Bt) do { __builtin_amdgcn_s_setprio(1); _Pragma("unroll") for (int m = 0; m < 4; ++m) _Pragma("unroll") for (int n = 0; n < 2; ++n) _Pragma("unroll") for (int k = 0; k < 2; ++k) \
        acc[ai][bj][m][n] = __builtin_amdgcn_mfma_f32_16x16x32_bf16(Bt[n][k], At[m][k], acc[ai][bj][m][n], 0, 0, 0); __builtin_amdgcn_s_setprio(0); } while (0)
#define PG8_WAIT_V(n) asm volatile("s_waitcnt vmcnt(" #n ")" ::: "memory")
#define PG8_WAIT_L(n) asm volatile("s_waitcnt lgkmcnt(" #n ")" ::: "memory")
#define PG8_BAR __builtin_amdgcn_s_barrier()
#define PG8_SCHED __builtin_amdgcn_sched_barrier(0)
    Unit cur, nxt; int ui = 0;
    if (!S.next(0, cur)) return;
    f32x4 acc[2][2][4][2];
#pragma unroll
    for (int a = 0; a < 2; ++a)
#pragma unroll
        for (int b = 0; b < 2; ++b)
#pragma unroll
            for (int m = 0; m < 4; ++m)
#pragma unroll
                for (int n = 0; n < 2; ++n) acc[a][b][m][n] = (f32x4){0.f, 0.f, 0.f, 0.f};
    bf16x8 At[4][2], B0[2][2], B1[2][2];
    const char* cA = (const char*)g.A + (size_t)cur.pm * tstep; const char* cB = (const char*)g.Bt + (size_t)cur.pn * tstep;
    S.a_ready(cur);
    if constexpr (SP2) {
        PG8_STAGE(PG8_SB(0, 0), cB, voffB); PG8_STAGE(PG8_SB(0, 1), cB + hstep, voffB); PG8_STAGE(PG8_SA(0, 0), cA, voffA); PG8_STAGE(PG8_SA(0, 1), cA + hstep, voffA);
        if (wr == 1) PG8_BAR;
        PG8_WAIT_V(2); PG8_BAR;
        PG8_STAGE(PG8_SB(1, 0), cB + kstep, voffB); PG8_STAGE(PG8_SA(1, 0), cA + kstep, voffA); PG8_STAGE(PG8_SB(1, 1), cB + hstep + kstep, voffB);
        PG8_WAIT_V(6); PG8_BAR;
    } else {
        PG8_STAGE(PG8_SB(0, 0), cB, voffB); PG8_STAGE(PG8_SA(0, 0), cA, voffA); PG8_STAGE(PG8_SB(0, 1), cB + hstep, voffB); PG8_STAGE(PG8_SA(0, 1), cA + hstep, voffA);
        if (wr == 1) PG8_BAR;
        PG8_WAIT_V(4); PG8_BAR;
        PG8_STAGE(PG8_SB(1, 0), cB + kstep, voffB); PG8_STAGE(PG8_SA(1, 0), cA + kstep, voffA); PG8_STAGE(PG8_SB(1, 1), cB + hstep + kstep, voffB);
        PG8_WAIT_V(6); PG8_BAR;
    }
    for (;;) {
        const bool has_next = S.next(ui + 1, nxt);
        const char* nA = has_next ? (const char*)g.A + (size_t)nxt.pm * tstep : cA; const char* nB = has_next ? (const char*)g.Bt + (size_t)nxt.pn * tstep : cB;
        for (int t = 0; t < nt; t += 2) {
            const bool last = (t == nt - 2);
            const char* a1 = cA + (size_t)(t + 1) * kstep;
            const char* a2 = last ? nA : cA + (size_t)(t + 2) * kstep; const char* b2 = last ? nB : cB + (size_t)(t + 2) * kstep;
            const char* a3 = a2 + kstep; const char* b3 = b2 + kstep;
            if (last && has_next) S.a_ready(nxt);
            if constexpr (SP2) {
            PG8_LDB(B0, 0, 0); PG8_LDB(B1, 0, 1); PG8_SCHED; PG8_LDA(At, 0, 0); PG8_STAGE(PG8_SA(1, 1), a1 + hstep, voffA);
            PG8_WAIT_V(8); PG8_WAIT_L(0); PG8_BAR; PG8_MMA(0, 0, At, B0); PG8_MMA(0, 1, At, B1); PG8_BAR; PG8_SCHED;
            PG8_LDA(At, 0, 1); PG8_STAGE(PG8_SB(0, 0), b2, voffB); PG8_STAGE(PG8_SB(0, 1), b2 + hstep, voffB); PG8_STAGE(PG8_SA(0, 0), a2, voffA);
            PG8_WAIT_V(8); PG8_WAIT_L(0); PG8_BAR; PG8_MMA(1, 0, At, B0); PG8_MMA(1, 1, At, B1); PG8_BAR; PG8_SCHED;
            PG8_LDB(B0, 1, 0); PG8_LDB(B1, 1, 1); PG8_SCHED; PG8_LDA(At, 1, 0); PG8_STAGE(PG8_SA(0, 1), a2 + hstep, voffA);
            PG8_WAIT_V(8); PG8_WAIT_L(0); PG8_BAR; PG8_MMA(0, 0, At, B0); PG8_MMA(0, 1, At, B1); PG8_BAR; PG8_SCHED;
            PG8_LDA(At, 1, 1); PG8_STAGE(PG8_SB(1, 0), b3, voffB); PG8_STAGE(PG8_SB(1, 1), b3 + hstep, voffB); PG8_STAGE(PG8_SA(1, 0), a3, voffA);
            PG8_WAIT_V(8); PG8_WAIT_L(0); PG8_BAR; PG8_MMA(1, 0, At, B0); PG8_MMA(1, 1, At, B1); PG8_BAR; PG8_SCHED;
            } else {
            PG8_LDB(B0, 0, 0); PG8_SCHED; PG8_LDA(At, 0, 0); PG8_STAGE(PG8_SA(1, 1), a1 + hstep, voffA);
            PG8_WAIT_L(8); PG8_BAR; PG8_WAIT_L(0); PG8_MMA(0, 0, At, B0); PG8_BAR; PG8_SCHED;
            PG8_LDB(B1, 0, 1); PG8_STAGE(PG8_SB(0, 0), b2, voffB);
            PG8_BAR; PG8_WAIT_L(0); PG8_MMA(0, 1, At, B1); PG8_BAR;
            PG8_LDA(At, 0, 1); PG8_STAGE(PG8_SA(0, 0), a2, voffA);
            PG8_BAR; PG8_WAIT_L(0); PG8_MMA(1, 0, At, B0); PG8_BAR; PG8_SCHED;
            PG8_STAGE(PG8_SB(0, 1), b2 + hstep, voffB);
            PG8_WAIT_V(6); PG8_BAR; PG8_MMA(1, 1, At, B1); PG8_BAR;
            PG8_LDB(B0, 1, 0); PG8_SCHED; PG8_LDA(At, 1, 0); PG8_STAGE(PG8_SA(0, 1), a2 + hstep, voffA);
            PG8_WAIT_L(8); PG8_BAR; PG8_WAIT_L(0); PG8_MMA(0, 0, At, B0); PG8_BAR; PG8_SCHED;
            PG8_LDB(B1, 1, 1); PG8_STAGE(PG8_SB(1, 0), b3, voffB);
            PG8_BAR; PG8_WAIT_L(0); PG8_MMA(0, 1, At, B1); PG8_BAR;
            PG8_LDA(At, 1, 1); PG8_STAGE(PG8_SA(1, 0), a3, voffA);
            PG8_BAR; PG8_WAIT_L(0); PG8_MMA(1, 0, At, B0); PG8_BAR; PG8_SCHED;
            PG8_STAGE(PG8_SB(1, 1), b3 + hstep, voffB);
            PG8_WAIT_V(6); PG8_BAR; PG8_MMA(1, 1, At, B1); PG8_BAR;
            }
        }
        if constexpr (ALIGN_EPI) { if (wr == 0) PG8_BAR; }
        if constexpr (!Epi::AFTER_DRAIN) { E(acc, cur, wr, wc, fr, fq); S.done(cur); }
        if (!has_next) break;
#pragma unroll
        for (int a = 0; a < 2; ++a)
#pragma unroll
            for (int b = 0; b < 2; ++b)
#pragma unroll
                for (int m = 0; m < 4; ++m)
#pragma unroll
                    for (int n = 0; n < 2; ++n) acc[a][b][m][n] = (f32x4){0.f, 0.f, 0.f, 0.f};
        cur = nxt; cA = nA; cB = nB; ++ui;
        if constexpr (ALIGN_EPI) { if (wr == 1) PG8_BAR; }
    }
    PG8_WAIT_V(0);
    if constexpr (!ALIGN_EPI) { if (wr == 0) PG8_BAR; }
    PG8_BAR;
    if constexpr (Epi::AFTER_DRAIN) { E.fused(acc, cur, wr, wc, fr, fq, lds, wid, lane); S.done(cur); }
#undef PG8_SA
#undef PG8_SB
#undef PG8_STAGE
#undef PG8_LDA
#undef PG8_LDB
#undef PG8_MMA
#undef PG8_WAIT_V
#undef PG8_WAIT_L
#undef PG8_BAR
#undef PG8_SCHED
}
}

#define XB_TMO      128
#define XB_XCNT(j)  (256  + 64 * (j))
#define XB_XSUB(j)  (1280 + 64 * (j))
#define XB_XGEN(j)  (2304 + 64 * (j))
#define XB_TOP      3328
#define XB_TOPGEN   3392
#define XCD_BAR_WORDS 3456
#define XB_SPIN_CAP (1u << 18)

__device__ __forceinline__ unsigned xb_ld(unsigned* p)              { return __hip_atomic_load(p, __ATOMIC_RELAXED, __HIP_MEMORY_SCOPE_AGENT); }
__device__ __forceinline__ unsigned xb_add(unsigned* p, unsigned v) { return __hip_atomic_fetch_add(p, v, __ATOMIC_RELAXED, __HIP_MEMORY_SCOPE_AGENT); }
__device__ __forceinline__ unsigned xb_xcc_id() { return (unsigned)__builtin_amdgcn_s_getreg((3 << 11) | 20) & 0xFu; }
#define XB_SPIN(cond, bar) do { unsigned _sp = 0; while (cond) { __builtin_amdgcn_s_sleep(1); \
    if ((++_sp & 255u) == 0u) { if (xb_ld(&(bar)[XB_TMO])) break; if (_sp > XB_SPIN_CAP) { atomicAdd(&(bar)[XB_TMO], 1u); break; } } } } while (0)

struct XcdBarrier {
    unsigned* bar; unsigned x;
    volatile LAS unsigned* st;
};

__device__ __forceinline__ XcdBarrier xcd_barrier_post(unsigned* bar, volatile LAS unsigned* st) {
    XcdBarrier b; b.bar = bar; b.x = xb_xcc_id(); b.st = st;
    if (threadIdx.x == 0) (void)xb_add(&bar[XB_XCNT(b.x)], 1u);
    return b;
}
__device__ __forceinline__ void xcd_barrier_complete(unsigned* bar, unsigned x, unsigned& nloc, unsigned& nx) {
    const unsigned G = gridDim.x * gridDim.y * gridDim.z;
    unsigned sum, cnt, mine, sp = 0u;
    for (;;) {
        sum = 0u; cnt = 0u; mine = 0u;
#pragma unroll
        for (unsigned j = 0; j < 16; ++j) { const unsigned c = xb_ld(&bar[XB_XCNT(j)]); sum += c; cnt += (c > 0u) ? 1u : 0u; mine = (j == x) ? c : mine; }
        if (sum == G) break;
        __builtin_amdgcn_s_sleep(1);
        if ((++sp & 255u) == 0u) { if (xb_ld(&bar[XB_TMO])) break; if (sp > XB_SPIN_CAP) { atomicAdd(&bar[XB_TMO], 1u); break; } }
    }
    nloc = mine > 0u ? mine : 1u; nx = cnt > 0u ? cnt : 1u;
}

__device__ __forceinline__ void xcd_barrier(const XcdBarrier& b) {
    asm volatile("s_waitcnt vmcnt(0)" ::: "memory");
    __syncthreads();
    if (threadIdx.x == 0) {
        unsigned* bar = b.bar;
        __builtin_amdgcn_s_waitcnt(0);
        unsigned nloc = b.st[0], nx = b.st[1];
        if (nloc == 0u) { xcd_barrier_complete(bar, b.x, nloc, nx); b.st[0] = nloc; b.st[1] = nx; }
        const unsigned old = xb_add(&bar[XB_XSUB(b.x)], 1u);
        const unsigned gen = old / nloc;
        if (old + 1u == (gen + 1u) * nloc) {
            __builtin_amdgcn_fence(__ATOMIC_RELEASE, "agent");
            asm volatile("s_waitcnt vmcnt(0)" ::: "memory");
            const unsigned og = xb_add(&bar[XB_TOP], 1u);
            const unsigned tg = og / nx;
            if (og + 1u == (tg + 1u) * nx) xb_add(&bar[XB_TOPGEN], 1u);
            else XB_SPIN(xb_ld(&bar[XB_TOPGEN]) == tg, bar);
            __builtin_amdgcn_fence(__ATOMIC_ACQUIRE, "agent");
            xb_add(&bar[XB_XGEN(b.x)], 1u);
            asm volatile("s_waitcnt vmcnt(0)" ::: "memory");
        } else {
            XB_SPIN(xb_ld(&bar[XB_XGEN(b.x)]) == gen, bar);
            __builtin_amdgcn_fence(__ATOMIC_ACQUIRE, "agent");
            asm volatile("s_waitcnt vmcnt(0)" ::: "memory");
        }
    }
    __syncthreads();
}

typedef pg8::bf16_t bf16_t;
typedef pg8::f32x4 f32x4;
typedef unsigned u32x2 __attribute__((ext_vector_type(2)));
typedef unsigned u32x4 __attribute__((ext_vector_type(4)));
constexpr int NWAVES = 8, NTHR = 512;
constexpr int RING_BYTES = 131072, LDSCTL_OFF = RING_BYTES, MISC_OFF = LDSCTL_OFF + 320, LDS_BYTES = 147456;
constexpr int NPHASE = 18;

struct Args { const float* in[33]; float* out; unsigned char* ws; int ph_lo, ph_hi, li, pad; };

__device__ __forceinline__ float bf2f(bf16_t h) { return __uint_as_float(((unsigned)h) << 16); }
__device__ __forceinline__ float sigmoidf_(float x) { return 1.f / (1.f + __expf(-x)); }
__device__ __forceinline__ float siluf_(float x) { return x / (1.f + __expf(-x)); }
__device__ __forceinline__ float wave_sum(float v) {
#pragma unroll
    for (int o = 1; o < 64; o <<= 1) v += __shfl_xor(v, o);
    return v;
}
__device__ __forceinline__ int row_cond(int r) { return r < MX ? (r >> 11) : 16; }
__device__ __forceinline__ const float* modp(const float* MOD, int l, int cond, int which) { return MOD + ((size_t)(l * 17 + cond) * 6 + which) * 1024; }

__device__ __forceinline__ void ph_mod(const Args& a, LAS unsigned char* lds, int tid) {
    asm volatile("" : "+v"(tid));
    LAS float* ssilu = (LAS float*)lds;
    LAS float* part = (LAS float*)(lds + 69632);
    const int lane = tid & 63, w = tid >> 6;
    if (blockIdx.x < 192) {
        for (int idx = tid; idx < 17 * 1024; idx += NTHR) { const int r = idx >> 10, k = idx & 1023; const float c = (r < 16) ? a.in[1][r * D + k] : a.in[3][k]; ssilu[idx] = siluf_(c); }
    }
    __syncthreads();
    float* MOD = (float*)(a.ws + WS_MOD);
    for (int item = blockIdx.x; item < 192; item += gridDim.x) {
        const int l = item / 96, cb = item % 96;
        const float* wm = a.in[4] + (size_t)l * D * 6144 + cb * 64 + lane;
        float acc[17];
#pragma unroll
        for (int r = 0; r < 17; ++r) acc[r] = 0.f;
        for (int k = w * 128; k < w * 128 + 128; ++k) { const float wv = wm[(size_t)k * 6144];
#pragma unroll
            for (int r = 0; r < 17; ++r) acc[r] += ssilu[r * 1024 + k] * wv; }
#pragma unroll
        for (int r = 0; r < 17; ++r) part[(w * 17 + r) * 64 + lane] = acc[r];
        __syncthreads();
        for (int o = tid; o < 17 * 64; o += NTHR) { const int r = o >> 6, col = o & 63; float s = a.in[5][l * 6144 + cb * 64 + col];
#pragma unroll
            for (int w2 = 0; w2 < 8; ++w2) s += part[(w2 * 17 + r) * 64 + col];
            MOD[(size_t)(l * 17 + r) * 6144 + cb * 64 + col] = s; }
        __syncthreads();
    }
}
__device__ __forceinline__ void ph_tables(const Args& a, int tid) {
    asm volatile("" : "+v"(tid));
    const size_t gtid = (size_t)blockIdx.x * NTHR + tid, gsz = (size_t)gridDim.x * NTHR;
    float* POS = (float*)(a.ws + WS_POS);
    for (size_t idx = gtid; idx < (size_t)SEQ * D; idx += gsz) {
        const int t = (int)(idx >> 10), ch = (int)(idx & 1023), q = ch >> 8, i = ch & 255;
        const float f = expf(-9.210340371976184f * (float)i / 256.0f);
        const float p = (q < 2) ? (float)(t >> 6) : (float)(t & 63);
        const float ang = p * f;
        POS[idx] = (q & 1) ? cosf(ang) : sinf(ang);
    }
    bf16_t* DX = (bf16_t*)(a.ws + WS_DFTX); bf16_t* DC = (bf16_t*)(a.ws + WS_DFTC);
    for (size_t idx = gtid; idx < (size_t)2048 * 4096 + 256 * 512; idx += gsz) {
        if (idx < (size_t)2048 * 4096) {
            const int k = (int)(idx >> 12), kk = (int)(idx & 4095), t = kk & 2047, ii = (k * t) & 2047;
            const float v = (kk < 2048) ? cospif((float)ii / 1024.f) : -sinpif((float)ii / 1024.f);
            DX[idx] = (bf16_t)f2bf(v * 0.022097086912079608f);
        } else {
            const int j = (int)(idx - (size_t)2048 * 4096), k = j >> 9, kk = j & 511, t = kk & 255, ii = (k * t) & 255;
            const float v = (kk < 256) ? cospif((float)ii / 128.f) : -sinpif((float)ii / 128.f);
            DC[j] = (bf16_t)f2bf(v * 0.0625f);
        }
    }
    float* WCS = (float*)(a.ws + WS_WCS);
    for (size_t idx = gtid; idx < 65536; idx += gsz) {
        const int i = (int)idx, d = i & 63, c = (i >> 6) & 63, s = (i >> 12) & 1, g = (i >> 13) & 3, l = i >> 15;
        const float* fw = a.in[24] + (size_t)(l * 4 + g) * 4096;
        float acc = 0.f;
        for (int m = 0; m < 64; ++m) { const int ii = (m * c) & 63; const float tr = s ? sinpif((float)ii / 32.f) : cospif((float)ii / 32.f); acc += tr * fw[m * 64 + d]; }
        WCS[i] = acc * 0.125f;
    }
    bf16_t* LTp = (bf16_t*)(a.ws + WS_LT);
    for (size_t idx = gtid; idx < (size_t)2 * 2 * 2 * 256 * 64; idx += gsz) {
        const int i = (int)idx, k = i & 63, ch = (i >> 6) & 255, d = (i >> 14) & 1, which = (i >> 15) & 1, l = i >> 16;
        LTp[i] = (bf16_t)f2bf((which ? a.in[11] : a.in[9])[((size_t)(l * 2 + d) * 64 + k) * GW + ch]);
    }
}
__device__ __forceinline__ int colmap(int n, int mode) {
    if (mode == 0) return n;
    if (mode == 1) { if (n < 1152) return n; if (n < 1280) return -1; return n - 128; }
    const int tile = n >> 8, half = (n >> 7) & 1, j = n & 127; return half * DFF + tile * 128 + j;
}
__device__ __forceinline__ void transpose_item(const float* W, int K, int Nsrc, int Ndst, bf16_t* WT, int mode, LAS float* scr, int item, int lane) {
    const int nblk = Ndst / 32, kb = item / nblk, nb = item % nblk, k0 = 64 * kb, n0 = 32 * nb;
    const int sc0 = colmap(n0, mode);
#pragma unroll 8
    for (int i = 0; i < 32; ++i) { const int kk = 2 * i + (lane >> 5); scr[kk * 33 + (lane & 31)] = (sc0 >= 0) ? W[(size_t)(k0 + kk) * Nsrc + sc0 + (lane & 31)] : 0.f; }
    LDS_WAIT(); asm volatile("" ::: "memory");
    const int c = lane & 7;
#pragma unroll
    for (int j = 0; j < 4; ++j) { const int n = (lane >> 3) + 8 * j; const LAS float* s = scr + (8 * c) * 33 + n;
        u32x4 o; o.x = pk2(s[0 * 33], s[1 * 33]); o.y = pk2(s[2 * 33], s[3 * 33]); o.z = pk2(s[4 * 33], s[5 * 33]); o.w = pk2(s[6 * 33], s[7 * 33]);
        *(u32x4*)(WT + (size_t)(n0 + n) * K + k0 + 8 * c) = o; }
    LDS_WAIT(); asm volatile("" ::: "memory");
}
__device__ __forceinline__ void ph_weights(const Args& a, LAS unsigned char* lds, int tid) {
    asm volatile("" : "+v"(tid));
    const int wave = tid >> 6, lane = tid & 63;
    LAS float* scr = (LAS float*)(lds + wave * 16384);
    const int gw = blockIdx.x * NWAVES + wave, NGW = gridDim.x * NWAVES;
    constexpr int I_IN = 16 * 64, I_O = 16 * 32, I_1 = 16 * 176, I_2 = 44 * 32, I_L = I_IN + I_O + I_1 + I_2;
    for (int it = gw; it < 2 * I_L; it += NGW) {
        const int l = it / I_L; int r = it % I_L;
        if (r < I_IN) { transpose_item(a.in[6] + (size_t)l * D * INC, D, INC, 2048, (bf16_t*)(a.ws + WS_WIN) + (size_t)l * 2048 * D, 1, scr, r, lane); continue; } r -= I_IN;
        if (r < I_O) { transpose_item(a.in[26] + (size_t)l * D * D, D, D, D, (bf16_t*)(a.ws + WS_WOUT) + (size_t)l * D * D, 0, scr, r, lane); continue; } r -= I_O;
        if (r < I_1) { transpose_item(a.in[31] + (size_t)l * D * 5632, D, 5632, 5632, (bf16_t*)(a.ws + WS_W1) + (size_t)l * 5632 * D, 2, scr, r, lane); continue; } r -= I_1;
        transpose_item(a.in[32] + (size_t)l * DFF * D, DFF, D, D, (bf16_t*)(a.ws + WS_W2) + (size_t)l * D * DFF, 0, scr, r, lane);
    }
}
__device__ __forceinline__ void ph_wf_init(const Args& a, int tid) {
    asm volatile("" : "+v"(tid));
    const size_t gtid = (size_t)blockIdx.x * NTHR + tid, gsz = (size_t)gridDim.x * NTHR;
    for (size_t idx = gtid; idx < (size_t)1 << 20; idx += gsz) {
        const int i = (int)idx, d = i & 63, dm = (i >> 6) & 1023, g = (i >> 16) & 3, s = (i >> 18) & 1, l = i >> 19;
        const float* wi = a.in[6] + ((size_t)l * D + dm) * INC + 1920 + g * 64;
        const float* wc = (const float*)(a.ws + WS_WCS) + (size_t)(((l * 4 + g) * 2 + s) * 64) * 64 + d;
        float acc = 0.f;
        for (int c = 0; c < 64; ++c) acc += wi[c] * wc[c * 64];
        ((bf16_t*)(a.ws + WS_WF))[((size_t)l * 512 + s * 256 + g * 64 + d) * 1024 + dm] = (bf16_t)f2bf(acc);
    }
    const float* MOD = (const float*)(a.ws + WS_MOD);
    for (size_t idx4 = gtid; idx4 < (size_t)MT * 256; idx4 += gsz) {
        const int r = (int)(idx4 >> 8), c = (int)(idx4 & 255) * 4;
        const int cond = row_cond(r);
        f32x4 v;
        if (r < MX) { v = *(const f32x4*)(a.in[0] + (size_t)r * D + c) + *(const f32x4*)((const float*)(a.ws + WS_POS) + (size_t)(r & 2047) * D + c); *(f32x4*)(a.out + (size_t)r * D + c) = v; }
        else { v = *(const f32x4*)(a.in[2] + (size_t)(r - MX) * D + c); *(f32x4*)((float*)(a.ws + WS_XSC) + (size_t)(r - MX) * D + c) = v; }
        const f32x4 sh = *(const f32x4*)(modp(MOD, 0, cond, 0) + c), sc = *(const f32x4*)(modp(MOD, 0, cond, 1) + c);
        const f32x4 h = v * (sc + 1.0f) + sh;
        u32x2 w; w.x = pk2(h[0], h[1]); w.y = pk2(h[2], h[3]);
        *(u32x2*)((bf16_t*)(a.ws + WS_A) + (size_t)r * D + c) = w;
    }
}
__device__ __forceinline__ void ph_pool(const Args& a, LAS unsigned char* lds, int tid, int l, int rows) {
    asm volatile("" : "+v"(tid));
    const int half = tid >> 8, ch = tid & 255, g = ch >> 6;
    LAS float* sd = (LAS float*)lds + half * 256;
    const float* pw = a.in[18] + (size_t)(l * 4 + g) * 4096 + (ch & 63);
    const float psc = a.in[19][l * GW + ch];
    for (int it = blockIdx.x; it < rows / 2; it += gridDim.x) {
        const int row = 2 * it + half;
        const int t = row < MX ? (row & 2047) : ((row - MX) & 255), Ls = row < MX ? SEQ : CTXL;
        const bf16_t* Z = (const bf16_t*)(a.ws + WS_Z) + (size_t)row * ZW + ZC_POOL + ch;
        const int w = 2 << g;
        int lo = t - w / 2; if (lo < 0) lo = 0;
        int hi = t + w - w / 2; if (hi > Ls) hi = Ls;
        float s = 0.f;
        for (int i = lo; i < hi; ++i) s += bf2f(Z[(ptrdiff_t)(i - t) * ZW]);
        sd[ch] = s / (float)(hi - lo) - bf2f(Z[0]);
        __syncthreads();
        float acc = 0.f;
        for (int c = 0; c < 64; ++c) acc += sd[g * 64 + c] * pw[c * 64];
        ((bf16_t*)(a.ws + WS_CAT))[(size_t)row * D + 256 + ch] = (bf16_t)f2bf(acc * psc);
        __syncthreads();
    }
}
__device__ __forceinline__ void ph_gmlp(const Args& a, LAS unsigned char* lds, int tid, int l, int rows) {
    asm volatile("" : "+v"(tid));
    const int half = tid >> 8, t2 = tid & 255, p = t2 >> 1, hf = t2 & 1;
    LAS float* vln = (LAS float*)lds + half * (128 * 65);
    const int ntask = rows / 128 * 4;
    for (int it = blockIdx.x; it < ntask / 2; it += gridDim.x) {
        const int task = 2 * it + half, chunk = task >> 2, g = task & 3;
        const int rowb = chunk * 128;
        const bf16_t* Z = (const bf16_t*)(a.ws + WS_Z) + (size_t)(rowb + p) * ZW;
        float v[32]; float s = 0.f;
#pragma unroll
        for (int c = 0; c < 32; ++c) { v[c] = bf2f(Z[ZC_GV + g * 64 + hf * 32 + c]); s += v[c]; }
        s += __shfl_xor(s, 1);
        const float mu = s * (1.f / 64.f); float q = 0.f;
#pragma unroll
        for (int c = 0; c < 32; ++c) { v[c] -= mu; q += v[c] * v[c]; }
        q += __shfl_xor(q, 1);
        const float rstd = rsqrtf(q * (1.f / 64.f) + LN_EPS);
#pragma unroll
        for (int c = 0; c < 32; ++c) { const int cc = g * 64 + hf * 32 + c; vln[p * 65 + hf * 32 + c] = v[c] * rstd * a.in[20][l * GW + cc] + a.in[21][l * GW + cc]; }
        __syncthreads();
        const float* ws = a.in[22] + ((size_t)(l * 4 + g) * 128 + p) * 128;
        float acc[32];
#pragma unroll
        for (int c = 0; c < 32; ++c) acc[c] = 0.f;
        for (int qq = 0; qq < 128; ++qq) { const float wv = ws[qq];
#pragma unroll
            for (int c = 0; c < 32; ++c) acc[c] += wv * vln[qq * 65 + hf * 32 + c]; }
        const float bs = a.in[23][(l * 4 + g) * 128 + p];
        bf16_t* o = (bf16_t*)(a.ws + WS_CAT) + (size_t)(rowb + p) * D + 512 + g * 64 + hf * 32;
#pragma unroll
        for (int c = 0; c < 32; ++c) o[c] = (bf16_t)f2bf(bf2f(Z[ZC_GU + g * 64 + hf * 32 + c]) * (acc[c] + bs));
        __syncthreads();
    }
}
__device__ __forceinline__ void ph_readout(const Args& a, LAS unsigned char* lds, int tid, int l, int rows) {
    asm volatile("" : "+v"(tid));
    const int half = tid >> 8, ch = tid & 255, h = ch >> 6;
    LAS float* sg = (LAS float*)lds + half * 128;
    const float* conv = a.in[7] + (size_t)l * 3 * 768 + 512 + ch;
    const float c0 = conv[0], c1 = conv[768], c2 = conv[1536];
    const float gng = a.in[16][l * GW + ch], gnb = a.in[17][l * GW + ch];
    const float* g2 = a.in[12] + (size_t)l * 128 * GW + ch;
    for (int it = blockIdx.x; it < rows / 2; it += gridDim.x) {
        const int row = 2 * it + half;
        const int t = row < MX ? (row & 2047) : ((row - MX) & 255), Ls = row < MX ? SEQ : CTXL;
        const bf16_t* Z = (const bf16_t*)(a.ws + WS_Z) + (size_t)row * ZW;
        const bf16_t* Yf = (const bf16_t*)(a.ws + WS_Y) + (size_t)row * GW;
        const bf16_t* Yb = Yf + (size_t)MT * GW;
        const float* BS = (const float*)(a.ws + WS_BS) + (size_t)row * 8;
        if (ch < 128) sg[ch] = bf2f(Z[ZC_DG + ch]);
        __syncthreads();
        const float y = bf2f(Yf[ch]) + bf2f(Yb[ch]);
        const float mu = wave_sum(y) * (1.f / 64.f);
        const float dv = y - mu;
        const float var = wave_sum(dv * dv) * (1.f / 64.f);
        float v = c1 * bf2f(Z[ZC_V + ch]);
        if (t > 0) v += c0 * bf2f(Z[ZC_V + ch - ZW]);
        if (t < Ls - 1) v += c2 * bf2f(Z[ZC_V + ch + ZW]);
        float gate = 0.f;
        for (int j = 0; j < 128; ++j) gate += sg[j] * g2[j * GW];
        const float o = (dv * rsqrtf(var + GN_EPS) * gng + gnb + (BS[h * 2] + BS[h * 2 + 1]) * v) * gate;
        ((bf16_t*)(a.ws + WS_CAT))[(size_t)row * D + ch] = (bf16_t)f2bf(o);
        __syncthreads();
    }
}
__device__ __forceinline__ void ph_scan_naive(const Args& a, LAS unsigned char* lds, int tid, int l) {
    asm volatile("" : "+v"(tid));
    if (tid >= 64) return;
    LAS float* sv = (LAS float*)lds;
    const int lane = tid;
    for (int bid = blockIdx.x; bid < 128; bid += gridDim.x) {
        const int d = bid & 1, h = (bid >> 1) & 3, b = bid >> 3;
        const int ch = h * 64 + lane;
        const bf16_t* Z = (const bf16_t*)(a.ws + WS_Z);
        bf16_t* Y = (bf16_t*)(a.ws + WS_Y) + (size_t)d * MT * GW;
        float* BS = (float*)(a.ws + WS_BS);
        const float* conv = a.in[7] + (size_t)l * 3 * 768;
        float cw[3][3];
#pragma unroll
        for (int q = 0; q < 3; ++q)
#pragma unroll
            for (int tp = 0; tp < 3; ++tp) cw[q][tp] = conv[tp * 768 + q * 256 + ch];
        const float w0 = a.in[8][(l * 2 + d) * GW + ch], a0 = a.in[10][(l * 2 + d) * GW + ch];
        const float* w2 = a.in[9] + (size_t)(l * 2 + d) * 64 * GW + ch;
        const float* a2 = a.in[11] + (size_t)(l * 2 + d) * 64 * GW + ch;
        const float kkw = a.in[13][l * GW + ch], kaw = a.in[14][l * GW + ch], rkw = a.in[15][l * GW + ch];
        float S[64];
#pragma unroll
        for (int k = 0; k < 64; ++k) S[k] = 0.f;
        for (int seg = 0; seg < 2; ++seg) {
            const int Ls = seg == 0 ? CTXL : SEQ;
            const int base = seg == 0 ? MX + b * CTXL : b * SEQ;
            for (int s = 0; s < Ls; ++s) {
                const int t = d ? (Ls - 1 - s) : s;
                const size_t row = (size_t)(base + t);
                const bf16_t* zr = Z + row * ZW;
                float rkv[3];
#pragma unroll
                for (int q = 0; q < 3; ++q) {
                    const int col = q * 256 + ch;
                    float x = cw[q][1] * bf2f(zr[col]);
                    if (t > 0) x += cw[q][0] * bf2f(zr[col - ZW]);
                    if (t < Ls - 1) x += cw[q][2] * bf2f(zr[col + ZW]);
                    rkv[q] = x;
                }
                const float r = rkv[0], k = rkv[1], v = rkv[2];
                const float kkr = k * kkw;
                const float nrm = sqrtf(wave_sum(kkr * kkr));
                const float kk = kkr / fmaxf(nrm, 1e-12f);
                float lw = w0, av = a0;
                for (int j = 0; j < 64; ++j) { lw += bf2f(zr[ZC_DW + d * 64 + j]) * w2[j * GW]; av += bf2f(zr[ZC_DA + d * 64 + j]) * a2[j * GW]; }
                const float nx = -lw;
                const float sp = fmaxf(nx, 0.f) + log1pf(expf(-fabsf(nx)));
                const float logw = -sp - 0.5f;
                const float w = expf(-expf(logw));
                const float aa = 1.f / (1.f + expf(-av));
                const float kd = k * (1.f + (aa - 1.f) * kaw);
                const float bsum = wave_sum(r * kd * rkw);
                if (lane == 0) BS[row * 8 + h * 2 + d] = bsum;
                LDS_WAIT(); asm volatile("" ::: "memory");
                sv[lane] = w; sv[64 + lane] = kk; sv[128 + lane] = kk * aa; sv[192 + lane] = kd; sv[256 + lane] = r;
                LDS_WAIT(); asm volatile("" ::: "memory");
                float skk = 0.f;
#pragma unroll
                for (int q = 0; q < 64; ++q) skk -= S[q] * sv[64 + q];
                float y = 0.f;
#pragma unroll
                for (int q = 0; q < 64; ++q) { S[q] = S[q] * sv[q] + skk * sv[128 + q] + v * sv[192 + q]; y += S[q] * sv[256 + q]; }
                Y[row * GW + ch] = (bf16_t)f2bf(y);
            }
        }
    }
}

template <int CTRL> __device__ __forceinline__ float dppf(float x) { return __builtin_bit_cast(float, __builtin_amdgcn_mov_dpp(__builtin_bit_cast(int, x), CTRL, 0xf, 0xf, true)); }
__device__ __forceinline__ float red16(float x) { x += dppf<0xB1>(x); x += dppf<0x4E>(x); x += dppf<0x141>(x); x += dppf<0x128>(x); return x; }
typedef float f32x2_ __attribute__((ext_vector_type(2)));
typedef float f32x16_ __attribute__((ext_vector_type(16)));
typedef short bf16x8_ __attribute__((ext_vector_type(8)));
constexpr int SCV = 0, SCVV = 40960, SCYB = 45056, SCSA = 49152;
__device__ __forceinline__ void ph_scan(const Args& a, LAS unsigned char* lds, int tid, int l) {
    asm volatile("" : "+v"(tid));
    const int lane = tid & 63, wv = __builtin_amdgcn_readfirstlane(tid >> 6);
    LAS float* VEC = (LAS float*)(lds + SCV); LAS float* VV = (LAS float*)(lds + SCVV); LAS float* YB = (LAS float*)(lds + SCYB); LAS float* SA = (LAS float*)(lds + SCSA);
    const bf16_t* Z = (const bf16_t*)(a.ws + WS_Z);
    for (int task = blockIdx.x; task < 256; task += gridDim.x) {
        const int half = task & 1, d = (task >> 1) & 1, h = (task >> 2) & 3, b = task >> 4;
        const int which = (wv >> 1) & 1, chh = wv & 1;
        const bf16_t* LT = (const bf16_t*)(a.ws + WS_LT) + ((size_t)((l * 2 + which) * 2 + d) * 256 + h * 64 + chh * 32 + (lane & 31)) * 64 + 8 * (lane >> 5);
        bf16x8_ Bf[4];
#pragma unroll
        for (int ks = 0; ks < 4; ++ks) Bf[ks] = *(const bf16x8_*)(LT + 16 * ks);
        const float bias1 = (which ? a.in[10] : a.in[8])[(l * 2 + d) * GW + h * 64 + chh * 32 + (lane & 31)];
        const int zc1 = (which ? ZC_DA : ZC_DW) + d * 64 + 8 * (lane >> 5);
        const int tau = tid >> 4, cq = tid & 15, c4 = 4 * cq, gch = h * 64 + c4;
        f32x4 cw[3][3];
#pragma unroll
        for (int q = 0; q < 3; ++q)
#pragma unroll
            for (int tp = 0; tp < 3; ++tp) cw[q][tp] = *(const f32x4*)(a.in[7] + (size_t)l * 2304 + tp * 768 + q * 256 + gch);
        const f32x4 kkw = *(const f32x4*)(a.in[13] + l * GW + gch), kaw = *(const f32x4*)(a.in[14] + l * GW + gch), rkw = *(const f32x4*)(a.in[15] + l * GW + gch);
        const int slot = d ? 31 - tau : tau;
        const int g = lane >> 5, c = lane & 31, ra = 4 * wv + 2 * g;
        float Sa0 = 0.f, Sa1 = 0.f, Sb0 = 0.f, Sb1 = 0.f;
        bf16x8_ Af[4]; u32x2 zt[3][3];
        auto load_chunk = [&](int ci) {
            const int isx = ci >= 8, cj = isx ? ci - 8 : ci, Ls = isx ? SEQ : CTXL, base = isx ? b * SEQ : MX + b * CTXL;
            const int t0 = d ? Ls - 32 * (cj + 1) : 32 * cj;
            if (wv < 4) {
                const bf16_t* zp = Z + (size_t)(base + t0 + (lane & 31)) * ZW + zc1;
#pragma unroll
                for (int ks = 0; ks < 4; ++ks) Af[ks] = *(const bf16x8_*)(zp + 16 * ks);
            }
            const int t = t0 + tau;
#pragma unroll
            for (int tp = 0; tp < 3; ++tp) {
                const int tt = t + tp - 1; const bool ok = (tt >= 0) && (tt < Ls);
                const bf16_t* zp = Z + (size_t)(base + (ok ? tt : t)) * ZW + gch;
#pragma unroll
                for (int q = 0; q < 3; ++q) { u32x2 v = *(const u32x2*)(zp + q * 256); if (!ok) { v.x = 0u; v.y = 0u; } zt[q][tp] = v; }
            }
        };
        load_chunk(0);
        for (int ci = 0; ci < 72; ++ci) {
            const int isx = ci >= 8, cj = isx ? ci - 8 : ci, Ls = isx ? SEQ : CTXL, base = isx ? b * SEQ : MX + b * CTXL;
            const int t0 = d ? Ls - 32 * (cj + 1) : 32 * cj;
            if (wv < 4) {
                f32x16_ acc;
#pragma unroll
                for (int r = 0; r < 16; ++r) acc[r] = 0.f;
#pragma unroll
                for (int ks = 0; ks < 4; ++ks) acc = __builtin_amdgcn_mfma_f32_32x32x16_bf16(Af[ks], Bf[ks], acc, 0, 0, 0);
#pragma unroll
                for (int r = 0; r < 16; ++r) {
                    const int tt = (r & 3) + 8 * (r >> 2) + 4 * (lane >> 5);
                    const float x = acc[r] + bias1;
                    const float sg = __builtin_amdgcn_rcpf(1.0f + __builtin_amdgcn_exp2f(-1.4426950408889634f * x));
                    if (which == 0) { const int sl = d ? 31 - tt : tt; VEC[sl * 320 + chh * 32 + (lane & 31)] = __builtin_amdgcn_exp2f(-1.4426950408889634f * 0.6065306597126334f * sg); }
                    else SA[tt * 64 + chh * 32 + (lane & 31)] = sg;
                }
            }
            LDS_WAIT(); __builtin_amdgcn_s_barrier(); asm volatile("" ::: "memory");
            {
                f32x4 rkv[3];
#pragma unroll
                for (int q = 0; q < 3; ++q) {
                    f32x4 s = {0.f, 0.f, 0.f, 0.f};
#pragma unroll
                    for (int tp = 0; tp < 3; ++tp) { const u32x2 z = zt[q][tp];
                        f32x4 zf; zf[0] = __uint_as_float(z.x << 16); zf[1] = __uint_as_float(z.x & 0xffff0000u); zf[2] = __uint_as_float(z.y << 16); zf[3] = __uint_as_float(z.y & 0xffff0000u);
                        s = s + cw[q][tp] * zf; }
                    rkv[q] = s;
                }
                const f32x4 r = rkv[0], k = rkv[1], v = rkv[2];
                const f32x4 kkr = k * kkw;
                const float ss = red16((kkr[0] * kkr[0] + kkr[1] * kkr[1]) + (kkr[2] * kkr[2] + kkr[3] * kkr[3]));
                const float inv = 1.0f / fmaxf(sqrtf(ss), 1e-12f);
                const f32x4 kk = kkr * inv;
                const f32x4 aa = *(const LAS f32x4*)(SA + tau * 64 + c4);
                const f32x4 bb = kk * aa;
                const f32x4 kd = k * ((aa - 1.0f) * kaw + 1.0f);
                const f32x4 bt = r * kd * rkw;
                const float bsum = red16((bt[0] + bt[1]) + (bt[2] + bt[3]));
                if (half == 0 && cq == 0) ((float*)(a.ws + WS_BS))[(size_t)(base + t0 + tau) * 8 + h * 2 + d] = bsum;
                LAS float* vp = VEC + slot * 320 + c4;
                *(LAS f32x4*)(vp + 64) = kk; *(LAS f32x4*)(vp + 128) = bb; *(LAS f32x4*)(vp + 192) = kd; *(LAS f32x4*)(vp + 256) = r;
                if ((c4 >> 5) == half) *(LAS f32x4*)(VV + slot * 32 + (c4 & 31)) = v;
            }
            LDS_WAIT(); __builtin_amdgcn_s_barrier(); asm volatile("" ::: "memory");
            if (ci + 1 < 72) load_chunk(ci + 1);
#pragma unroll 4
            for (int i = 0; i < 32; ++i) {
                const LAS float* vp = VEC + i * 320 + 2 * c;
                const f32x2_ w2 = *(const LAS f32x2_*)(vp), k2 = *(const LAS f32x2_*)(vp + 64), b2 = *(const LAS f32x2_*)(vp + 128), d2 = *(const LAS f32x2_*)(vp + 192), r2 = *(const LAS f32x2_*)(vp + 256);
                const f32x2_ vv = *(const LAS f32x2_*)(VV + i * 32 + ra);
                float pa = Sa0 * k2.x + Sa1 * k2.y, pb = Sb0 * k2.x + Sb1 * k2.y;
                { auto s = __builtin_amdgcn_permlane16_swap(__float_as_uint(pa), __float_as_uint(pb), false, false); pa = red16(__uint_as_float(s[0]) + __uint_as_float(s[1])); }
                auto q = __builtin_amdgcn_permlane16_swap(__float_as_uint(pa), __float_as_uint(pa), false, false);
                const float ska = -__uint_as_float(q[0]), skb = -__uint_as_float(q[1]);
                Sa0 = Sa0 * w2.x + (ska * b2.x + vv.x * d2.x); Sa1 = Sa1 * w2.y + (ska * b2.y + vv.x * d2.y);
                Sb0 = Sb0 * w2.x + (skb * b2.x + vv.y * d2.x); Sb1 = Sb1 * w2.y + (skb * b2.y + vv.y * d2.y);
                float ya = Sa0 * r2.x + Sa1 * r2.y, yb = Sb0 * r2.x + Sb1 * r2.y;
                { auto s = __builtin_amdgcn_permlane16_swap(__float_as_uint(ya), __float_as_uint(yb), false, false); ya = red16(__uint_as_float(s[0]) + __uint_as_float(s[1])); }
                if ((lane & 15) == 0) YB[i * 32 + ra + ((lane >> 4) & 1)] = ya;
            }
            LDS_WAIT(); __builtin_amdgcn_s_barrier(); asm volatile("" ::: "memory");
            {
                const int i = tid >> 4, rq = tid & 15, tt = d ? 31 - i : i;
                const f32x2_ y2 = *(const LAS f32x2_*)(YB + i * 32 + 2 * rq);
                *(unsigned*)((bf16_t*)(a.ws + WS_Y) + ((size_t)d * MT + base + t0 + tt) * GW + h * 64 + half * 32 + 2 * rq) = pk2(y2.x, y2.y);
            }
        }
        __syncthreads();
    }
}
__device__ __forceinline__ void ph_ln(const Args& a, int tid, const float* lg, const float* lb, int lA, int whichsh, int nrows) {
    asm volatile("" : "+v"(tid));
    const int wave = tid >> 6, lane = tid & 63;
    const float* MOD = (const float*)(a.ws + WS_MOD);
    for (int row = blockIdx.x * NWAVES + wave; row < nrows; row += gridDim.x * NWAVES) {
        float* xp = (row < MX) ? a.out + (size_t)row * D : (float*)(a.ws + WS_XSC) + (size_t)(row - MX) * D;
        f32x4 v[4]; float s = 0.f;
#pragma unroll
        for (int j = 0; j < 4; ++j) { v[j] = *(const f32x4*)(xp + j * 256 + lane * 4); s += (v[j][0] + v[j][1]) + (v[j][2] + v[j][3]); }
        const float mu = wave_sum(s) * (1.f / D); float q = 0.f;
#pragma unroll
        for (int j = 0; j < 4; ++j) { v[j] = v[j] - mu; q += (v[j][0] * v[j][0] + v[j][1] * v[j][1]) + (v[j][2] * v[j][2] + v[j][3] * v[j][3]); }
        const float rstd = rsqrtf(wave_sum(q) * (1.f / D) + LN_EPS);
        const int cond = row_cond(row);
#pragma unroll
        for (int j = 0; j < 4; ++j) {
            const int c = j * 256 + lane * 4;
            const f32x4 o = v[j] * rstd * *(const f32x4*)(lg + c) + *(const f32x4*)(lb + c);
            *(f32x4*)(xp + c) = o;
            if (lA >= 0) {
                const f32x4 sh = *(const f32x4*)(modp(MOD, lA, cond, whichsh) + c), sc = *(const f32x4*)(modp(MOD, lA, cond, whichsh + 1) + c);
                const f32x4 hh = o * (sc + 1.0f) + sh;
                u32x2 w; w.x = pk2(hh[0], hh[1]); w.y = pk2(hh[2], hh[3]);
                *(u32x2*)((bf16_t*)(a.ws + WS_A) + (size_t)row * D + c) = w;
            }
        }
    }
}

__global__ void __launch_bounds__(NTHR, 2) mk_fwd(Args a) {
    extern __shared__ __attribute__((aligned(16))) unsigned char lds_raw[];
    LAS unsigned char* lds = (LAS unsigned char*)lds_raw;
    volatile LAS unsigned* MISC = (volatile LAS unsigned*)(lds + MISC_OFF);
    int tid = threadIdx.x;
    const int G = gridDim.x, bx = blockIdx.x;
    for (int u = tid; u < (LDS_BYTES - LDSCTL_OFF) / 4; u += NTHR) ((LAS unsigned*)(lds + LDSCTL_OFF))[u] = 0u;
    __syncthreads();
    gu32* ctl = (gu32*)(a.ws + WS_CTL);
    XcdBarrier bar = xcd_barrier_post((unsigned*)(ctl + CW_BAR) + a.li * XCD_BAR_WORDS, MISC + 8);
    const int lo = a.ph_lo, hi = a.ph_hi;
#define IN(k) (lo <= (k) && (k) < hi)
#define SEAM(k) do { if (IN(k) && IN((k) + 1)) xcd_barrier(bar); } while (0)
    unsigned char* ws = a.ws;
    bf16_t* A = (bf16_t*)(ws + WS_A); bf16_t* Z = (bf16_t*)(ws + WS_Z); bf16_t* Cat = (bf16_t*)(ws + WS_CAT); bf16_t* H = (bf16_t*)(ws + WS_H);
    bf16_t* ZTX = (bf16_t*)(ws + WS_ZTX); bf16_t* ZTC = (bf16_t*)(ws + WS_ZTC);
    const float* MOD = (const float*)(ws + WS_MOD);

    if (IN(0)) { ph_mod(a, lds, tid); __syncthreads(); ph_tables(a, tid); ph_weights(a, lds, tid); }
    SEAM(0);
    if (IN(1)) { ph_wf_init(a, tid); }
    SEAM(1);
    for (int l = 0; l < 2; ++l) {
        const int pb = 2 + 8 * l;
        const bool last = (l == 1);
        const int rows = last ? MX : MT;
        const bf16_t* WinT = (const bf16_t*)(ws + WS_WIN) + (size_t)l * 2048 * 1024;
        const bf16_t* WfT = (const bf16_t*)(ws + WS_WF) + (size_t)l * 512 * 1024;
        const bf16_t* WoT = (const bf16_t*)(ws + WS_WOUT) + (size_t)l * D * D;
        const bf16_t* W1T = (const bf16_t*)(ws + WS_W1) + (size_t)l * 5632 * 1024;
        const bf16_t* W2T = (const bf16_t*)(ws + WS_W2) + (size_t)l * D * DFF;
        if (IN(pb + 0)) {
            { pg8::Gemm g{A, WinT, MT, ZW, D}; pg8::Order2 S{MX / 256, 8, MC / 256, last ? 5 : 8, G, bx}; pg8::EpiZ E{Z};
              pg8::gemm_phase<pg8::EpiZ, pg8::Order2, true, true>(lds, g, S, E); }
            { pg8::Gemm g{WfT, A, 512, rows, D}; pg8::Order2 S{2, rows / 256, 0, 0, G, bx}; pg8::EpiZT E{ZTX, ZTC};
              pg8::gemm_phase<pg8::EpiZT, pg8::Order2, true, true>(lds, g, S, E); }
        }
        SEAM(pb + 0);
        if (IN(pb + 1)) { ph_pool(a, lds, tid, l, rows); ph_gmlp(a, lds, tid, l, rows); ph_scan(a, lds, tid, l); }
        SEAM(pb + 1);
        if (IN(pb + 2)) {
            ph_readout(a, lds, tid, l, rows);
            __syncthreads();
            for (int j = 0; j < (last ? 1 : 2); ++j) {
                pg8::Gemm g{j == 0 ? (const bf16_t*)(ws + WS_DFTX) : (const bf16_t*)(ws + WS_DFTC), j == 0 ? ZTX : ZTC, j == 0 ? SEQ : CTXL, 4096, j == 0 ? 4096 : 512};
                pg8::Order2 S{j == 0 ? 8 : 1, 16, 0, 0, G, bx}; pg8::EpiFourier E{Cat, a.in[25] + l * GW, j == 0 ? 0 : MX, j == 0 ? SEQ : CTXL};
                pg8::gemm_phase<pg8::EpiFourier, pg8::Order2, true, true>(lds, g, S, E);
            }
        }
        SEAM(pb + 2);
        if (IN(pb + 3)) { pg8::Gemm g{Cat, WoT, rows, D, D}; pg8::Order2 S{rows / 256, 4, 0, 0, G, bx}; pg8::EpiRes E{a.out, (float*)(ws + WS_XSC), MOD + (size_t)(l * 17) * 6144 + 2 * 1024};
            pg8::gemm_phase<pg8::EpiRes, pg8::Order2, true, true>(lds, g, S, E); }
        SEAM(pb + 3);
        if (IN(pb + 4)) ph_ln(a, tid, a.in[27] + l * D, a.in[28] + l * D, l, 3, rows);
        SEAM(pb + 4);
        if (IN(pb + 5)) { pg8::Gemm g{A, W1T, rows, 5632, D}; pg8::Order2 S{rows / 256, 22, 0, 0, G, bx}; pg8::EpiSwiglu E{H};
            pg8::gemm_phase<pg8::EpiSwiglu, pg8::Order2, true, true>(lds, g, S, E); }
        SEAM(pb + 5);
        if (IN(pb + 6)) { pg8::Gemm g{H, W2T, rows, D, DFF}; pg8::Order2 S{rows / 256, 4, 0, 0, G, bx}; pg8::EpiRes E{a.out, (float*)(ws + WS_XSC), MOD + (size_t)(l * 17) * 6144 + 5 * 1024};
            pg8::gemm_phase<pg8::EpiRes, pg8::Order2, true, true>(lds, g, S, E); }
        SEAM(pb + 6);
        if (IN(pb + 7)) ph_ln(a, tid, a.in[29] + l * D, a.in[30] + l * D, last ? -1 : l + 1, 0, rows);
        if (!last) SEAM(pb + 7);
    }
#undef IN
#undef SEAM
}

#ifndef MK_CUTS
#define MK_CUTS {0, NPHASE}
#endif
extern "C" void kernel_launch(void* const* d_in, const int* in_sizes, int n_in, void* d_out, int out_size, void* d_ws, size_t ws_size, hipStream_t stream) {
    static int grid = 0;
    if (grid == 0) {
        if (n_in != 33 || ws_size < WS_END) { fprintf(stderr, "kernel_launch: unexpected n_in %d / ws_size %zu\n", n_in, ws_size); grid = -1; return; }
        int dev = 0, cus = 0, per_cu = 0;
        if (hipGetDevice(&dev) != hipSuccess || hipDeviceGetAttribute(&cus, hipDeviceAttributeMultiprocessorCount, dev) != hipSuccess) { grid = -1; return; }
        if (hipFuncSetAttribute((const void*)mk_fwd, hipFuncAttributeMaxDynamicSharedMemorySize, LDS_BYTES) != hipSuccess) { fprintf(stderr, "kernel_launch: hipFuncSetAttribute failed\n"); grid = -1; return; }
        if (hipOccupancyMaxActiveBlocksPerMultiprocessor(&per_cu, (const void*)mk_fwd, NTHR, LDS_BYTES) != hipSuccess || per_cu < 1) { fprintf(stderr, "kernel_launch: occupancy query says %d blocks per CU\n", per_cu); per_cu = 1; }
        (void)hipGetLastError();
        grid = cus;
    }
    if (grid < 0) return;
    (void)hipMemsetAsync((char*)d_ws + WS_CTL, 0, CTL_ZERO_BYTES, stream);
    Args a{};
    for (int i = 0; i < 33; ++i) a.in[i] = (const float*)d_in[i];
    a.out = (float*)d_out; a.ws = (unsigned char*)d_ws;
    const int cuts[] = MK_CUTS; const int ncut = (int)(sizeof(cuts) / sizeof(int)) - 1;
    for (int li = 0; li < ncut; ++li) {
        a.ph_lo = cuts[li]; a.ph_hi = cuts[li + 1]; a.li = li;
        hipLaunchKernelGGL(mk_fwd, dim3(grid), dim3(NTHR), LDS_BYTES, stream, a);
    }
}
```
